# Optimizing an MI355X kernel written in HIP

```python
import math
import jax, jax.numpy as jnp
from jax import lax
import numpy as np

D_MODEL = 2048
BATCH = 2
SEQ = 4096
DEPTH = 2

GRID_W = 64
CTX_LEN = 256
HEAD_DIM = 128
N_MOD = 9
FFN_HIDDEN = 5632
RMS_EPS = 1e-6
ROPE_THETA = 10000.0
Q_BLOCK = 128

N_HEADS_TOTAL = D_MODEL // HEAD_DIM
A_HEADS = (3 * N_HEADS_TOTAL) // 8
A_KV_HEADS = A_HEADS // 3
B_HEADS = N_HEADS_TOTAL // 4
C_HEADS = N_HEADS_TOTAL - A_HEADS - B_HEADS
B_SUB_DIM = HEAD_DIM // 2
A_WIDTH = A_HEADS * HEAD_DIM
A_KV_WIDTH = A_KV_HEADS * HEAD_DIM
B_WIDTH = B_HEADS * HEAD_DIM
C_WIDTH = C_HEADS * HEAD_DIM
MIX_WIDTH = A_WIDTH + B_WIDTH + C_WIDTH
IN_SIZES = (A_WIDTH, A_KV_WIDTH, A_KV_WIDTH, B_WIDTH, B_WIDTH, B_WIDTH, C_WIDTH, C_WIDTH, C_WIDTH)
IN_WIDTH = A_WIDTH + 2 * A_KV_WIDTH + 3 * B_WIDTH + 3 * C_WIDTH
NA_ROWS_MAX = 8
NA_COLS = 16

kernel_name = "hybrid_headgroup_diffusion_block"


def rms_norm(x, gain=None):
    xf = x.astype(jnp.float32)
    y = xf * lax.rsqrt(jnp.mean(xf * xf, axis=-1, keepdims=True) + RMS_EPS)
    if gain is not None:
        y = y * gain.astype(jnp.float32)
    return y.astype(x.dtype)


def modulate(xn, shift, scale):
    return xn * (1 + scale) + shift


def swiglu(h, w_gu, w_down):
    gate, up = jnp.split(h @ w_gu, 2, axis=-1)
    return (jax.nn.silu(gate) * up) @ w_down


def rope_1d(x, pos):
    half = x.shape[-1] // 2
    freqs = ROPE_THETA ** (-jnp.arange(half, dtype=jnp.float32) / half)
    ang = pos.astype(jnp.float32)[:, None] * freqs[None, :]
    cos = jnp.cos(ang)[None, :, None, :]
    sin = jnp.sin(ang)[None, :, None, :]
    xf = x.astype(jnp.float32)
    x1, x2 = xf[..., :half], xf[..., half:]
    return jnp.concatenate([x1 * cos - x2 * sin, x1 * sin + x2 * cos], axis=-1).astype(x.dtype)


def rope_2d(x, row, col):
    d = x.shape[-1] // 2
    return jnp.concatenate([rope_1d(x[..., :d], row), rope_1d(x[..., d:], col)], axis=-1)


def sweep_query_blocks(fn, q):
    b, s = q.shape[0], q.shape[1]
    nb = s // Q_BLOCK
    qb = jnp.moveaxis(q.reshape((b, nb, Q_BLOCK) + q.shape[2:]), 1, 0)
    out = lax.map(fn, qb)
    return jnp.moveaxis(out, 0, 1).reshape((b, s) + out.shape[3:])


def gqa_attend(q, k, v):
    b, nq, h, dh = q.shape
    hkv = k.shape[2]
    qg = q.reshape(b, nq, hkv, h // hkv, dh)
    s = jnp.einsum('bqkgd,blkd->bkgql', qg, k, preferred_element_type=jnp.float32) * (dh ** -0.5)
    p = jax.nn.softmax(s, axis=-1).astype(v.dtype)
    o = jnp.einsum('bkgql,blkd->bqkgd', p, v)
    return o.reshape(b, nq, h, dh)


def diff_attend(q, k, v, lam):
    ds = q.shape[-1]
    s = jnp.einsum('bqhmd,blhmd->bhmql', q, k, preferred_element_type=jnp.float32) * (ds ** -0.5)
    p = jax.nn.softmax(s, axis=-1)
    w = p[:, :, 0] - lam * p[:, :, 1]
    return jnp.einsum('bhql,blhd->bqhd', w.astype(v.dtype), v)


def neighborhood_attend(q, k, v, k_ctx, v_ctx, rel_bias):
    b, s, h, dh = q.shape
    rows = s // GRID_W
    wr = min(NA_ROWS_MAX, rows)
    n_win = wr * NA_COLS
    kg = k.reshape(b, rows, GRID_W, h, dh)
    vg = v.reshape(b, rows, GRID_W, h, dh)
    qg = jnp.moveaxis(q.reshape(b, rows, GRID_W, h, dh), 1, 0)
    row_start = jnp.clip(jnp.arange(rows) - wr // 2, 0, rows - wr)
    col_start = jnp.clip(jnp.arange(GRID_W) - NA_COLS // 2, 0, GRID_W - NA_COLS)
    col_idx = col_start[:, None] + jnp.arange(NA_COLS)[None, :]
    off_c = col_idx - jnp.arange(GRID_W)[:, None] + (NA_COLS - 1)
    scale = dh ** -0.5

    def row_block(args):
        r, q_row = args
        rs = row_start[r]
        k_win = lax.dynamic_slice_in_dim(kg, rs, wr, axis=1)[:, :, col_idx]
        v_win = lax.dynamic_slice_in_dim(vg, rs, wr, axis=1)[:, :, col_idx]
        off_r = rs + jnp.arange(wr) - r + (NA_ROWS_MAX - 1)
        bias = rel_bias[:, off_r[:, None, None], off_c[None, :, :]]
        s_win = jnp.einsum('bjhd,bajchd->bhjac', q_row, k_win,
                           preferred_element_type=jnp.float32) * scale
        s_win = s_win + jnp.transpose(bias, (0, 2, 1, 3))[None].astype(jnp.float32)
        s_ctx = jnp.einsum('bjhd,bnhd->bhjn', q_row, k_ctx,
                           preferred_element_type=jnp.float32) * scale
        scores = jnp.concatenate([s_win.reshape(b, h, GRID_W, n_win), s_ctx], axis=-1)
        p = jax.nn.softmax(scores, axis=-1).astype(v.dtype)
        p_win = p[..., :n_win].reshape(b, h, GRID_W, wr, NA_COLS)
        p_ctx = p[..., n_win:]
        return (jnp.einsum('bhjac,bajchd->bjhd', p_win, v_win)
                + jnp.einsum('bhjn,bnhd->bjhd', p_ctx, v_ctx))

    out = lax.map(row_block, (jnp.arange(rows), qg))
    return jnp.moveaxis(out, 0, 1).reshape(b, s, h, dh)


def split_in_proj(p):
    offsets = []
    acc = 0
    for size in IN_SIZES[:-1]:
        acc += size
        offsets.append(acc)
    return jnp.split(p, offsets, axis=-1)


def heads(t, h, d):
    return t.reshape(t.shape[0], t.shape[1], h, d)


def mixer_a(xq, xk, xv, gq, gk, gv, q_gain, k_gain, out_gain, row, col, with_ctx):
    b, s, _ = xq.shape
    n = gq.shape[1]
    lq = rope_2d(rms_norm(heads(xq, A_HEADS, HEAD_DIM), q_gain), row, col)
    lk = rope_2d(rms_norm(heads(xk, A_KV_HEADS, HEAD_DIM), k_gain), row, col)
    ck = rms_norm(heads(gk, A_KV_HEADS, HEAD_DIM), k_gain)
    cv = heads(gv, A_KV_HEADS, HEAD_DIM)
    k_all = jnp.concatenate([ck, lk], axis=1)
    v_all = jnp.concatenate([cv, heads(xv, A_KV_HEADS, HEAD_DIM)], axis=1)
    lat = sweep_query_blocks(lambda qb: gqa_attend(qb, k_all, v_all), lq)
    lat = rms_norm(lat.reshape(b, s, A_WIDTH), out_gain)
    ctx_out = None
    if with_ctx:
        cq = rms_norm(heads(gq, A_HEADS, HEAD_DIM), q_gain)
        ctx_out = rms_norm(gqa_attend(cq, ck, cv).reshape(b, n, A_WIDTH), out_gain)
    return lat, ctx_out


def mixer_b(xq, xk, xv, gq, gk, gv, q_gain, k_gain, lam_vecs, out_gain, lam_init, row, col, with_ctx):
    b, s, _ = xq.shape
    n = gq.shape[1]

    def qk_heads(t):
        return t.reshape(t.shape[0], t.shape[1], B_HEADS, 2, B_SUB_DIM)

    def rope_sub(t):
        return rope_2d(t.reshape(b, s, 2 * B_HEADS, B_SUB_DIM), row, col).reshape(b, s, B_HEADS, 2, B_SUB_DIM)

    lq = rope_sub(rms_norm(qk_heads(xq), q_gain))
    lk = rope_sub(rms_norm(qk_heads(xk), k_gain))
    ck = rms_norm(qk_heads(gk), k_gain)
    cv = heads(gv, B_HEADS, HEAD_DIM)
    k_all = jnp.concatenate([ck, lk], axis=1)
    v_all = jnp.concatenate([cv, heads(xv, B_HEADS, HEAD_DIM)], axis=1)
    lv = lam_vecs.astype(jnp.float32)
    lam = jnp.exp(jnp.sum(lv[0] * lv[1])) - jnp.exp(jnp.sum(lv[2] * lv[3])) + lam_init
    lat = sweep_query_blocks(lambda qb: diff_attend(qb, k_all, v_all, lam), lq)
    lat = (rms_norm(lat, out_gain) * (1.0 - lam_init)).reshape(b, s, B_WIDTH)
    ctx_out = None
    if with_ctx:
        cq = rms_norm(qk_heads(gq), q_gain)
        co = diff_attend(cq, ck, cv, lam)
        ctx_out = (rms_norm(co, out_gain) * (1.0 - lam_init)).reshape(b, n, B_WIDTH)
    return lat, ctx_out


def mixer_c(xq, xk, xv, gq, gk, gv, q_gain, k_gain, rel_bias, out_gain, with_ctx):
    b, s, _ = xq.shape
    n = gq.shape[1]
    lq = rms_norm(heads(xq, C_HEADS, HEAD_DIM), q_gain)
    lk = rms_norm(heads(xk, C_HEADS, HEAD_DIM), k_gain)
    ck = rms_norm(heads(gk, C_HEADS, HEAD_DIM), k_gain)
    cv = heads(gv, C_HEADS, HEAD_DIM)
    lat = neighborhood_attend(lq, lk, heads(xv, C_HEADS, HEAD_DIM), ck, cv, rel_bias)
    lat = rms_norm(lat.reshape(b, s, C_WIDTH), out_gain)
    ctx_out = None
    if with_ctx:
        cq = rms_norm(heads(gq, C_HEADS, HEAD_DIM), q_gain)
        ctx_out = rms_norm(gqa_attend(cq, ck, cv).reshape(b, n, C_WIDTH), out_gain)
    return lat, ctx_out


def setup_inputs(seed: int = 0) -> dict:
    key = jax.random.key(seed)
    ks = jax.random.split(key, 24)
    L, D, F = DEPTH, D_MODEL, FFN_HIDDEN
    nrm = jax.random.normal
    f32 = jnp.float32

    def gain(k, shape):
        return 1.0 + 0.1 * nrm(k, shape, f32)

    return {
        "x": nrm(ks[0], (BATCH, SEQ, D), f32),
        "c": nrm(ks[1], (BATCH, D), f32),
        "ctx": nrm(ks[2], (BATCH, CTX_LEN, D), f32),
        "c_ctx": nrm(ks[3], (D,), f32),
        "w_mod": nrm(ks[4], (L, D, N_MOD * D), f32) * (0.5 * D ** -0.5),
        "b_mod": nrm(ks[5], (L, N_MOD * D), f32) * 0.02,
        "ffn1_w_gu": nrm(ks[6], (L, D, 2 * F), f32) * (D ** -0.5),
        "ffn1_w_down": nrm(ks[7], (L, F, D), f32) * (F ** -0.5),
        "ffn2_w_gu": nrm(ks[8], (L, D, 2 * F), f32) * (D ** -0.5),
        "ffn2_w_down": nrm(ks[9], (L, F, D), f32) * (F ** -0.5),
        "w_in": nrm(ks[10], (L, D, IN_WIDTH), f32) * (D ** -0.5),
        "w_out": nrm(ks[11], (L, MIX_WIDTH, D), f32) * (MIX_WIDTH ** -0.5),
        "a_q_gain": gain(ks[12], (L, HEAD_DIM)),
        "a_k_gain": gain(ks[13], (L, HEAD_DIM)),
        "a_out_gain": gain(ks[14], (L, A_WIDTH)),
        "b_q_gain": gain(ks[15], (L, B_SUB_DIM)),
        "b_k_gain": gain(ks[16], (L, B_SUB_DIM)),
        "b_lambda": nrm(ks[17], (L, 4, B_SUB_DIM), f32) * 0.1,
        "b_out_gain": gain(ks[18], (L, HEAD_DIM)),
        "c_q_gain": gain(ks[19], (L, HEAD_DIM)),
        "c_k_gain": gain(ks[20], (L, HEAD_DIM)),
        "c_rel_bias": nrm(ks[21], (L, C_HEADS, 2 * NA_ROWS_MAX - 1, 2 * NA_COLS - 1), f32) * 0.1,
        "c_out_gain": gain(ks[22], (L, C_WIDTH)),
    }


def reference(x, c, ctx, c_ctx, w_mod, b_mod, ffn1_w_gu, ffn1_w_down, ffn2_w_gu, ffn2_w_down,
              w_in, w_out, a_q_gain, a_k_gain, a_out_gain, b_q_gain, b_k_gain, b_lambda, b_out_gain,
              c_q_gain, c_k_gain, c_rel_bias, c_out_gain):
    b, s, d = x.shape
    t = jnp.arange(s, dtype=jnp.int32)
    row = t // GRID_W
    col = t % GRID_W
    g = ctx
    for l in range(DEPTH):
        with_ctx = l < DEPTH - 1
        mx = (jax.nn.silu(c) @ w_mod[l] + b_mod[l]).reshape(b, N_MOD, 1, d)
        mg = (jax.nn.silu(c_ctx) @ w_mod[l] + b_mod[l]).reshape(N_MOD, 1, 1, d)

        x = x + 0.5 * mx[:, 2] * swiglu(modulate(rms_norm(x), mx[:, 0], mx[:, 1]), ffn1_w_gu[l], ffn1_w_down[l])
        g = g + 0.5 * mg[2] * swiglu(modulate(rms_norm(g), mg[0], mg[1]), ffn1_w_gu[l], ffn1_w_down[l])

        xn = modulate(rms_norm(x), mx[:, 3], mx[:, 4])
        gn = modulate(rms_norm(g), mg[3], mg[4])
        px = split_in_proj(xn @ w_in[l])
        pg = split_in_proj(gn @ w_in[l])
        lam_init = 0.8 - 0.6 * math.exp(-0.3 * l)
        a_lat, a_ctx = mixer_a(px[0], px[1], px[2], pg[0], pg[1], pg[2],
                               a_q_gain[l], a_k_gain[l], a_out_gain[l], row, col, with_ctx)
        b_lat, b_ctx = mixer_b(px[3], px[4], px[5], pg[3], pg[4], pg[5],
                               b_q_gain[l], b_k_gain[l], b_lambda[l], b_out_gain[l], lam_init, row, col, with_ctx)
        c_lat, c_ctx_o = mixer_c(px[6], px[7], px[8], pg[6], pg[7], pg[8],
                                 c_q_gain[l], c_k_gain[l], c_rel_bias[l], c_out_gain[l], with_ctx)
        x = x + mx[:, 5] * (jnp.concatenate([a_lat, b_lat, c_lat], axis=-1) @ w_out[l])
        x = x + 0.5 * mx[:, 8] * swiglu(modulate(rms_norm(x), mx[:, 6], mx[:, 7]), ffn2_w_gu[l], ffn2_w_down[l])
        if with_ctx:
            g = g + mg[5] * (jnp.concatenate([a_ctx, b_ctx, c_ctx_o], axis=-1) @ w_out[l])
            g = g + 0.5 * mg[8] * swiglu(modulate(rms_norm(g), mg[6], mg[7]), ffn2_w_gu[l], ffn2_w_down[l])
    return x
```

```cpp
#include <hip/hip_runtime.h>
#include <hip/hip_cooperative_groups.h>
#include <cstdio>
#include <cstdint>
namespace cg = cooperative_groups;

#ifndef MK_MULTI
#define MK_MULTI 0
#endif

#define GAS __attribute__((address_space(1)))
#define LAS __attribute__((address_space(3)))
typedef unsigned short bf16_t;
typedef short bf16x8 __attribute__((ext_vector_type(8)));
typedef float f32x4 __attribute__((ext_vector_type(4)));
typedef float f32x2 __attribute__((ext_vector_type(2)));
typedef unsigned u32x4 __attribute__((ext_vector_type(4)));
typedef unsigned u32x2 __attribute__((ext_vector_type(2)));

constexpr int DM = 2048, BATCH = 2, SEQ = 4096, DEPTH = 2, GRIDW = 64, CTX = 256, NMOD = 9, FF = 5632;
constexpr int ML = BATCH * SEQ, MC = BATCH * CTX, MT = ML + MC;
constexpr int INW = 5120, MODW = NMOD * DM;
constexpr int OFF_AQ = 0, OFF_AK = 768, OFF_AV = 1024, OFF_BQ = 1280, OFF_BK = 1792, OFF_BV = 2304, OFF_CQ = 2816, OFF_CK = 3584, OFF_CV = 4352;
constexpr float RMS_EPS = 1e-6f;
constexpr int NWAVES = 8, NTHR = 512;

constexpr size_t MiB = 1u << 20;
constexpr size_t WS_CTL = 0, CTL_ZERO_BYTES = 1 * MiB;
constexpr size_t WS_MOD = 65536;
constexpr size_t WS_SCAL = 1 * MiB;
constexpr size_t WS_W = 2 * MiB, WL_STRIDE = 160 * MiB;
constexpr size_t WO_GU1 = 0, WO_D1 = 44 * MiB, WO_IN = 66 * MiB, WO_OUT = 86 * MiB, WO_GU2 = 94 * MiB, WO_D2 = 138 * MiB;
constexpr size_t WS_X = 322 * MiB;
constexpr size_t WS_XN = 390 * MiB;
constexpr size_t WS_H = 424 * MiB;
constexpr size_t WS_P = 518 * MiB;
constexpr size_t WS_AO = 604 * MiB;
constexpr size_t WS_END = 640 * MiB;
static_assert(WS_MOD + (size_t)DEPTH * 3 * MODW * 4 <= CTL_ZERO_BYTES, "mod inside zero region");
static_assert(WS_X + (size_t)MT * DM * 4 <= WS_XN && WS_XN + (size_t)MT * DM * 2 <= WS_H && WS_H + (size_t)MT * FF * 2 <= WS_P && WS_P + (size_t)MT * INW * 2 <= WS_AO && WS_AO + (size_t)MT * DM * 2 <= WS_END, "ws map");

constexpr int RING_BYTES = 131072, LDS_BYTES = 147456;

__device__ __forceinline__ unsigned cvt_pk_bf16(float lo, float hi) { unsigned r; asm volatile("v_cvt_pk_bf16_f32 %0, %1, %2" : "=v"(r) : "v"(lo), "v"(hi)); return r; }
__device__ __forceinline__ float bf_lo(unsigned u) { return __uint_as_float(u << 16); }
__device__ __forceinline__ float bf_hi(unsigned u) { return __uint_as_float(u & 0xffff0000u); }
template <int CTRL> __device__ __forceinline__ float dpp_f(float v) { return __uint_as_float((unsigned)__builtin_amdgcn_update_dpp(0, (int)__float_as_uint(v), CTRL, 0xf, 0xf, true)); }
template <int NL> __device__ __forceinline__ float group_sum(float v) {
    v += dpp_f<0xB1>(v);
    v += dpp_f<0x4E>(v);
    v += dpp_f<0x141>(v);
    v += dpp_f<0x140>(v);
    if (NL >= 32) v += __uint_as_float((unsigned)__builtin_amdgcn_ds_swizzle((int)__float_as_uint(v), 0x401F));
    if (NL >= 64) { auto rr = __builtin_amdgcn_permlane32_swap(__float_as_uint(v), __float_as_uint(v), false, false); v = __uint_as_float(rr[0]) + __uint_as_float(rr[1]); }
    return v;
}
__device__ __forceinline__ float wave_sum(float v) { return group_sum<64>(v); }
__device__ __forceinline__ float silu_f(float v) { return v / (1.f + __expf(-v)); }
__device__ __forceinline__ void sincos_small(float x, float& s, float& c) {
    const float k = rintf(x * 0.636619772f);
    float r = fmaf(-k, 1.57079637e+0f, x); r = fmaf(-k, -4.37113883e-8f, r);
    const float r2 = r * r;
    float sp = fmaf(r2, 2.7557319e-6f, -1.9841270e-4f); sp = fmaf(sp, r2, 8.3333333e-3f); sp = fmaf(sp, r2, -1.6666667e-1f); sp = fmaf(sp * r2, r, r);
    float cp = fmaf(r2, 2.4801587e-5f, -1.3888889e-3f); cp = fmaf(cp, r2, 4.1666667e-2f); cp = fmaf(cp, r2, -0.5f); cp = fmaf(cp, r2, 1.f);
    const int q = ((int)k) & 3;
    const float ss = (q & 1) ? cp : sp, cc = (q & 1) ? sp : cp;
    s = (q & 2) ? -ss : ss;
    c = ((q + 1) & 2) ? -cc : cc;
}

namespace pg8 {
constexpr int BM = 256, BK = 64, HALF = 128, HTB = HALF * BK * 2, STAGE_BYTES = 8 * HTB, NXCD = 8, WGM = 8;
__host__ __device__ __forceinline__ int lds_byte(int r, int c) { const int st = (r >> 4) * 2 + (c >> 5), rr = r & 15, cc = c & 31, ob = rr * 64 + cc * 2; return st * 1024 + (ob ^ (((ob >> 9) & 1) << 5)); }
__host__ __device__ __forceinline__ void stage_rc(int b, int& R, int& C) { const int st = b / 1024, sb = b % 1024, swz = sb ^ (((sb >> 9) & 1) << 5); R = (st >> 1) * 16 + swz / 64; C = (st & 1) * 32 + (swz % 64) / 2; }
__host__ __device__ __forceinline__ int perm32(int rho) { const int n = rho >> 4, i = rho & 15; return 8 * (i >> 2) + 4 * n + (i & 3); }
struct Unit { int pm, pn, k0, nt, atomic; };
struct Gemm { const bf16_t* A; const bf16_t* Bt; int M, N, K; };
template <int M, int N, int K>
struct StaticOrder {
    static constexpr int nM = M / BM, nN = N / BM, nwg = nM * nN, ntk = K / BK;
    int G, c;
    __device__ __forceinline__ void init(int G_, int c_) { G = G_; c = c_; }
    __device__ __forceinline__ void map(int L, int& pm, int& pn) const {
        int wgid = L; { constexpr int q = nwg / NXCD, r = nwg % NXCD; const int xcd = wgid % NXCD, off = wgid / NXCD; wgid = (xcd < r ? xcd * (q + 1) : r * (q + 1) + (xcd - r) * q) + off; }
        constexpr int nig = WGM * nN; const int gid = wgid / nig, fm = gid * WGM, gsz = (nM - fm) < WGM ? (nM - fm) : WGM;
        pm = fm + ((wgid % nig) % gsz); pn = (wgid % nig) / gsz;
    }
    __device__ __forceinline__ bool next(int i, Unit& u) const {
        const int L = i * G + c; if (L >= nwg) return false;
        int pm, pn; map(L, pm, pn);
        u.pm = pm; u.pn = pn; u.k0 = 0; u.nt = ntk; u.atomic = 0; return true;
    }
};
template <int MLAT, int MTOT, int N, int K, int KS>
struct SplitTailOrder {
    StaticOrder<MLAT, N, K> lat;
    static constexpr int nlat = (MLAT / BM) * (N / BM), nN = N / BM, pm0 = MLAT / BM, ntail = ((MTOT - MLAT) / BM) * nN * KS, ntk_sub = K / BK / KS;
    static_assert(KS == 1 || (K / BK) % (2 * KS) == 0, "split-K pieces need an even number of K tiles");
    __device__ __forceinline__ void init(int G_, int c_) { lat.init(G_, c_); }
    __device__ __forceinline__ bool next(int i, Unit& u) const {
        const int L = i * lat.G + lat.c;
        if (L >= nlat + ntail) return false;
        const bool tail = L >= nlat;
        int pml, pnl; lat.map(tail ? 0 : L, pml, pnl);
        const int s = tail ? L - nlat : 0, un = s / KS, ks = s % KS;
        u.pm = tail ? pm0 + un / nN : pml; u.pn = tail ? un % nN : pnl; u.nt = tail ? ntk_sub : K / BK; u.k0 = tail ? ks * ntk_sub * BK : 0; u.atomic = tail ? 1 : 0;
        return true;
    }
};

struct EpiBf16 {
    static constexpr bool PERM = true;
    bf16_t* O; int ldc;
    __device__ __forceinline__ void operator()(const f32x4 (&acc)[2][2][4][2], const Unit& u, int wr, int wc, int fr, int fq) const {
        const int row0 = u.pm * BM + wr * 64 + fr, col0 = u.pn * BM + wc * 32 + 8 * fq;
#pragma unroll
        for (int ai = 0; ai < 2; ++ai)
#pragma unroll
            for (int m = 0; m < 4; ++m) { bf16_t* rowp = O + (size_t)(row0 + ai * HALF + m * 16) * ldc + col0;
#pragma unroll
                for (int bj = 0; bj < 2; ++bj) { const f32x4 v0 = acc[ai][bj][m][0], v1 = acc[ai][bj][m][1];
                    u32x4 w; w.x = cvt_pk_bf16(v0[0], v0[1]); w.y = cvt_pk_bf16(v0[2], v0[3]); w.z = cvt_pk_bf16(v1[0], v1[1]); w.w = cvt_pk_bf16(v1[2], v1[3]);
                    *(u32x4*)(rowp + bj * HALF) = w; } }
    }
};
struct EpiSwiglu {
    static constexpr bool PERM = true;
    bf16_t* O; int ldc;
    __device__ __forceinline__ void operator()(const f32x4 (&acc)[2][2][4][2], const Unit& u, int wr, int wc, int fr, int fq) const {
        const int row0 = u.pm * BM + wr * 64 + fr, col0 = u.pn * HALF + wc * 32 + 8 * fq;
#pragma unroll
        for (int ai = 0; ai < 2; ++ai)
#pragma unroll
            for (int m = 0; m < 4; ++m) { bf16_t* rowp = O + (size_t)(row0 + ai * HALF + m * 16) * ldc + col0;
                float h[8];
#pragma unroll
                for (int n = 0; n < 2; ++n)
#pragma unroll
                    for (int j = 0; j < 4; ++j) { const float g = acc[ai][0][m][n][j], up = acc[ai][1][m][n][j]; h[n * 4 + j] = g * __builtin_amdgcn_rcpf(1.f + __expf(-g)) * up; }
                u32x4 w; w.x = cvt_pk_bf16(h[0], h[1]); w.y = cvt_pk_bf16(h[2], h[3]); w.z = cvt_pk_bf16(h[4], h[5]); w.w = cvt_pk_bf16(h[6], h[7]);
                *(u32x4*)rowp = w; }
    }
};
struct EpiResid {
    static constexpr bool PERM = false;
    const float* Xin; float* Xout; const float* gate; float coef;
    __device__ __forceinline__ void operator()(const f32x4 (&acc)[2][2][4][2], const Unit& u, int wr, int wc, int fr, int fq) const {
        const int grp = u.pm < 16 ? 0 : (u.pm < 32 ? 1 : 2);
        const float* gp = gate + (size_t)grp * MODW;
        const int col0 = u.pn * BM + wc * 32 + 4 * fq;
        f32x4 gv[2][2];
#pragma unroll
        for (int bj = 0; bj < 2; ++bj)
#pragma unroll
            for (int n = 0; n < 2; ++n) gv[bj][n] = *(const f32x4*)(gp + col0 + bj * HALF + n * 16) * coef;
#pragma unroll
        for (int ai = 0; ai < 2; ++ai)
#pragma unroll
            for (int m = 0; m < 4; ++m) { const size_t off = (size_t)(u.pm * BM + ai * HALF + wr * 64 + m * 16 + fr) * DM + col0;
#pragma unroll
                for (int bj = 0; bj < 2; ++bj)
#pragma unroll
                    for (int n = 0; n < 2; ++n) {
                        if (u.atomic) { const f32x4 v = gv[bj][n] * acc[ai][bj][m][n]; float* xo = Xout + off + bj * HALF + n * 16;
#pragma unroll
                            for (int j = 0; j < 4; ++j) __hip_atomic_fetch_add(xo + j, v[j], __ATOMIC_RELAXED, __HIP_MEMORY_SCOPE_AGENT); }
                        else { const f32x4 xi = *(const f32x4*)(Xin + off + bj * HALF + n * 16);
                            *(f32x4*)(Xout + off + bj * HALF + n * 16) = xi + gv[bj][n] * acc[ai][bj][m][n]; } } }
    }
};

template <class Epi, class Sched>
__device__ __forceinline__ void gemm_phase(LAS unsigned char* lds, const Gemm g, const Sched& S, const Epi& E) {
    const int tid = threadIdx.x, wid = __builtin_amdgcn_readfirstlane(tid >> 6), lane = tid & 63, wr = wid >> 2, wc = wid & 3, fr = lane & 15, fq = lane >> 4;
    const int K = g.K;
    unsigned voffA[2], voffB[2];
#pragma unroll
    for (int i = 0; i < 2; ++i) { int R, C; stage_rc(tid * 16 + i * 8192, R, C); const int Rb = Epi::PERM ? ((R & ~31) + perm32(R & 31)) : R;
        voffA[i] = (unsigned)(R * K + C) * 2u; voffB[i] = (unsigned)(Rb * K + C) * 2u; }
    const size_t kstep = (size_t)(BK * 2);
    const size_t hstep = (size_t)HALF * K * 2;
    const size_t tstep = 2 * hstep;
    const unsigned ldsw = (unsigned)wid * 1024u;
    const int aoff = lds_byte(wr * 64 + fr, fq * 8), boff = lds_byte(wc * 32 + fr, fq * 8);
#define PG8_SA(b, h) (((b) * 2 + (h)) * HTB)
#define PG8_SB(b, h) ((4 + (b) * 2 + (h)) * HTB)
#define PG8_STAGE(bufoff, gbase, voff) do { _Pragma("unroll") for (int _i = 0; _i < 2; ++_i) \
        __builtin_amdgcn_global_load_lds((const unsigned*)((const char*)(gbase) + (voff)[_i]), (LAS unsigned*)(lds + (bufoff) + ldsw + _i * 8192), 16, 0, 0); } while (0)
#define PG8_LDA(dst, b, h) do { _Pragma("unroll") for (int m = 0; m < 4; ++m) _Pragma("unroll") for (int k = 0; k < 2; ++k) dst[m][k] = *(const LAS bf16x8*)(lds + PG8_SA(b, h) + aoff + m * 2048 + k * 1024); } while (0)
#define PG8_LDB(dst, b, h) do { _Pragma("unroll") for (int n = 0; n < 2; ++n) _Pragma("unroll") for (int k = 0; k < 2; ++k) dst[n][k] = *(const LAS bf16x8*)(lds + PG8_SB(b, h) + boff + n * 2048 + k * 1024); } while (0)
#define PG8_MMA(ai, bj, At, Bt) do { __builtin_amdgcn_s_setprio(1); _Pragma("unroll") for (int m = 0; m < 4; ++m) _Pragma("unroll") for (int n = 0; n < 2; ++n) _Pragma("unroll") for (int k = 0; k < 2; ++k) \
        acc[ai][bj][m][n] = __builtin_amdgcn_mfma_f32_16x16x32_bf16(Bt[n][k], At[m][k], acc[ai][bj][m][n], 0, 0, 0); __builtin_amdgcn_s_setprio(0); } while (0)
#define PG8_WAIT_V(n) asm volatile("s_waitcnt vmcnt(" #n ")" ::: "memory")
#define PG8_WAIT_L(n) asm volatile("s_waitcnt lgkmcnt(" #n ")" ::: "memory")
#define PG8_BAR __builtin_amdgcn_s_barrier()
#define PG8_SCHED __builtin_amdgcn_sched_barrier(0)
    Unit cur, nxt; int ui = 0;
    if (!S.next(0, cur)) return;
    f32x4 acc[2][2][4][2];
#pragma unroll
    for (int a = 0; a < 2; ++a)
#pragma unroll
        for (int b = 0; b < 2; ++b)
#pragma unroll
            for (int m = 0; m < 4; ++m)
#pragma unroll
                for (int n = 0; n < 2; ++n) acc[a][b][m][n] = (f32x4){0.f, 0.f, 0.f, 0.f};
    bf16x8 At[4][2], B0[2][2], B1[2][2];
    const char* cA = (const char*)g.A + (size_t)cur.pm * tstep + (size_t)cur.k0 * 2; const char* cB = (const char*)g.Bt + (size_t)cur.pn * tstep + (size_t)cur.k0 * 2;
    PG8_STAGE(PG8_SB(0, 0), cB, voffB); PG8_STAGE(PG8_SB(0, 1), cB + hstep, voffB); PG8_STAGE(PG8_SA(0, 0), cA, voffA); PG8_STAGE(PG8_SA(0, 1), cA + hstep, voffA);
    if (wr == 1) PG8_BAR;
    PG8_WAIT_V(2); PG8_BAR;
    PG8_STAGE(PG8_SB(1, 0), cB + kstep, voffB); PG8_STAGE(PG8_SA(1, 0), cA + kstep, voffA); PG8_STAGE(PG8_SB(1, 1), cB + hstep + kstep, voffB);
    PG8_WAIT_V(6); PG8_BAR;
    for (;;) {
        const bool has_next = S.next(ui + 1, nxt);
        const char* nA = has_next ? (const char*)g.A + (size_t)nxt.pm * tstep + (size_t)nxt.k0 * 2 : cA; const char* nB = has_next ? (const char*)g.Bt + (size_t)nxt.pn * tstep + (size_t)nxt.k0 * 2 : cB;
        const int nt = cur.nt;
        for (int t = 0; t < nt; t += 2) {
            const bool last = (t == nt - 2);
            const char* a1 = cA + (size_t)(t + 1) * kstep;
            const char* a2 = last ? nA : cA + (size_t)(t + 2) * kstep; const char* b2 = last ? nB : cB + (size_t)(t + 2) * kstep;
            const char* a3 = a2 + kstep; const char* b3 = b2 + kstep;
            PG8_LDB(B0, 0, 0); PG8_LDB(B1, 0, 1); PG8_SCHED; PG8_LDA(At, 0, 0); PG8_STAGE(PG8_SA(1, 1), a1 + hstep, voffA);
            PG8_WAIT_V(8); PG8_WAIT_L(0); PG8_BAR; PG8_MMA(0, 0, At, B0); PG8_MMA(0, 1, At, B1); PG8_BAR; PG8_SCHED;
            PG8_LDA(At, 0, 1); PG8_STAGE(PG8_SB(0, 0), b2, voffB); PG8_STAGE(PG8_SB(0, 1), b2 + hstep, voffB); PG8_STAGE(PG8_SA(0, 0), a2, voffA);
            PG8_WAIT_V(8); PG8_WAIT_L(0); PG8_BAR; PG8_MMA(1, 0, At, B0); PG8_MMA(1, 1, At, B1); PG8_BAR; PG8_SCHED;
            PG8_LDB(B0, 1, 0); PG8_LDB(B1, 1, 1); PG8_SCHED; PG8_LDA(At, 1, 0); PG8_STAGE(PG8_SA(0, 1), a2 + hstep, voffA);
            PG8_WAIT_V(8); PG8_WAIT_L(0); PG8_BAR; PG8_MMA(0, 0, At, B0); PG8_MMA(0, 1, At, B1); PG8_BAR; PG8_SCHED;
            PG8_LDA(At, 1, 1); PG8_STAGE(PG8_SB(1, 0), b3, voffB); PG8_STAGE(PG8_SB(1, 1), b3 + hstep, voffB); PG8_STAGE(PG8_SA(1, 0), a3, voffA);
            PG8_WAIT_V(8); PG8_WAIT_L(0); PG8_BAR; PG8_MMA(1, 0, At, B0); PG8_MMA(1, 1, At, B1); PG8_BAR; PG8_SCHED;
        }
        if (wr == 0) PG8_BAR;
        E(acc, cur, wr, wc, fr, fq);
        if (!has_next) break;
#pragma unroll
        for (int a = 0; a < 2; ++a)
#pragma unroll
            for (int b = 0; b < 2; ++b)
#pragma unroll
                for (int m = 0; m < 4; ++m)
#pragma unroll
                    for (int n = 0; n < 2; ++n) acc[a][b][m][n] = (f32x4){0.f, 0.f, 0.f, 0.f};
        cur = nxt; cA = nA; cB = nB; ++ui;
        if (wr == 1) PG8_BAR;
    }
    PG8_WAIT_V(0);
    PG8_BAR;
#undef PG8_SA
#undef PG8_SB
#undef PG8_STAGE
#undef PG8_LDA
#undef PG8_LDB
#undef PG8_MMA
#undef PG8_WAIT_V
#undef PG8_WAIT_L
#undef PG8_BAR
#undef PG8_SCHED
}
}

struct Args { const float* in[23]; float* out; unsigned char* ws; int ph_lo, ph_hi, coop, pad; };
enum { I_X = 0, I_C, I_CTX, I_CCTX, I_WMOD, I_BMOD, I_F1GU, I_F1D, I_F2GU, I_F2D, I_WIN, I_WOUT, I_AQG, I_AKG, I_AOG, I_BQG, I_BKG, I_BLAM, I_BOG, I_CQG, I_CKG, I_CRB, I_COG };

typedef const __attribute__((address_space(4))) Args* KArgs;
__device__ __forceinline__ KArgs get_args() { KArgs p = (KArgs)__builtin_amdgcn_kernarg_segment_ptr(); asm volatile("" : "+s"(p)); return p; }

struct Ctx {
    LAS unsigned char* lds; int tid, lane, wave, G, gw, NGW;
    unsigned char* ws;
};
extern __shared__ __attribute__((aligned(16))) unsigned char lds_raw[];
__device__ __forceinline__ Ctx make_ctx(KArgs ap) {
    Ctx F; int tid = threadIdx.x, bid = blockIdx.x, G = gridDim.x;
    asm volatile("" : "+v"(tid)); asm volatile("" : "+s"(bid)); asm volatile("" : "+s"(G));
    F.lds = (LAS unsigned char*)lds_raw; F.tid = tid; F.lane = tid & 63; F.wave = __builtin_amdgcn_readfirstlane(tid >> 6);
    F.G = G; F.gw = bid * NWAVES + F.wave; F.NGW = G * NWAVES; F.ws = ap->ws;
    return F;
}

__device__ __forceinline__ void transpose_item(const float* W, int K, int N, bf16_t* WT, int k0, int n0, int drow0, LAS float* scr, int lane) {
#pragma unroll 8
    for (int i = 0; i < 32; ++i) { const int kk = 2 * i + (lane >> 5); scr[kk * 33 + (lane & 31)] = W[(size_t)(k0 + kk) * N + n0 + (lane & 31)]; }
    asm volatile("s_waitcnt lgkmcnt(0)" ::: "memory");
    const int c = lane & 7;
#pragma unroll
    for (int j = 0; j < 4; ++j) { const int n = (lane >> 3) + 8 * j; const LAS float* s = scr + (8 * c) * 33 + n;
        u32x4 o; o.x = cvt_pk_bf16(s[0 * 33], s[1 * 33]); o.y = cvt_pk_bf16(s[2 * 33], s[3 * 33]); o.z = cvt_pk_bf16(s[4 * 33], s[5 * 33]); o.w = cvt_pk_bf16(s[6 * 33], s[7 * 33]);
        *(u32x4*)(WT + (size_t)(drow0 + n) * K + k0 + 8 * c) = o; }
    asm volatile("s_waitcnt lgkmcnt(0)" ::: "memory");
}

__device__ __forceinline__ void phase_prologue() {
    const KArgs ap = get_args(); Ctx F = make_ctx(ap);
#define a (*ap)
    LAS float* scr = (LAS float*)(F.lds + F.wave * 8448);
    LAS float* sil = (LAS float*)(F.lds + 73728);
    for (int i = F.tid; i < 3 * DM; i += NTHR) {
        const int g = i / DM, k = i % DM;
        const float v = (g == 0) ? a.in[I_C][k] : (g == 1) ? a.in[I_C][DM + k] : a.in[I_CCTX][k];
        sil[i] = silu_f(v);
    }
    __syncthreads();
    if (F.gw == 0) {
        for (int l = 0; l < DEPTH; ++l) {
            const float* lv = a.in[I_BLAM] + l * 256;
            const float s1 = wave_sum(lv[F.lane] * lv[64 + F.lane]), s2 = wave_sum(lv[128 + F.lane] * lv[192 + F.lane]);
            const float lam_init = (l == 0) ? 0.2f : 0.35550906f;
            if (F.lane == 0) ((float*)(F.ws + WS_SCAL))[l] = expf(s1) - expf(s2) + lam_init;
        }
    }
    {
        float* MOD = (float*)(F.ws + WS_MOD);
        constexpr int NCC = MODW / 256, NKS = 32, KS = DM / NKS, NIT = DEPTH * NCC * NKS;
        for (int it = F.gw; it < NIT; it += F.NGW) {
            const int l = it / (NCC * NKS), r = it % (NCC * NKS), cc = r / NKS, ks = r % NKS;
            const int col = cc * 256 + F.lane * 4;
            const float* W = a.in[I_WMOD] + (size_t)l * DM * MODW + col;
            f32x4 a0 = {0, 0, 0, 0}, a1 = a0, a2 = a0;
#pragma unroll 8
            for (int k = ks * KS; k < (ks + 1) * KS; ++k) {
                const f32x4 w = *(const f32x4*)(W + (size_t)k * MODW);
                const float s0 = sil[k], s1 = sil[DM + k], s2 = sil[2 * DM + k];
                a0 += w * s0; a1 += w * s1; a2 += w * s2;
            }
            if (ks == 0) { const f32x4 bv = *(const f32x4*)(a.in[I_BMOD] + (size_t)l * MODW + col); a0 += bv; a1 += bv; a2 += bv; }
            float* o = MOD + (size_t)l * 3 * MODW + col;
#pragma unroll
            for (int j = 0; j < 4; ++j) { atomicAdd(o + j, a0[j]); atomicAdd(o + MODW + j, a1[j]); atomicAdd(o + 2 * MODW + j, a2[j]); }
        }
    }
    {
        f32x4* X = (f32x4*)(F.ws + WS_X);
        const f32x4* xs = (const f32x4*)a.in[I_X]; const f32x4* cs = (const f32x4*)a.in[I_CTX];
        const size_t nl = (size_t)ML * DM / 4, nc = (size_t)MC * DM / 4;
        for (size_t i = (size_t)(F.gw / NWAVES) * NTHR + F.tid; i < nl + nc; i += (size_t)F.G * NTHR) X[i] = (i < nl) ? xs[i] : cs[i - nl];
    }
    {
        constexpr int IT_GU = (DM / 64) * (2 * FF / 32), IT_D = (FF / 64) * (DM / 32), IT_IN = (DM / 64) * (INW / 32), IT_OUT = (DM / 64) * (DM / 32);
        constexpr int IT_L = 2 * IT_GU + 2 * IT_D + IT_IN + IT_OUT;
        for (int it = F.gw; it < DEPTH * IT_L; it += F.NGW) {
            const int l = it / IT_L; int r = it % IT_L;
            unsigned char* wl = F.ws + WS_W + (size_t)l * WL_STRIDE;
            const float* W; int K, N; bf16_t* WT; bool gu = false;
            if (r < IT_GU) { W = a.in[I_F1GU] + (size_t)l * DM * 2 * FF; K = DM; N = 2 * FF; WT = (bf16_t*)(wl + WO_GU1); gu = true; }
            else if ((r -= IT_GU) < IT_GU) { W = a.in[I_F2GU] + (size_t)l * DM * 2 * FF; K = DM; N = 2 * FF; WT = (bf16_t*)(wl + WO_GU2); gu = true; }
            else if ((r -= IT_GU) < IT_D) { W = a.in[I_F1D] + (size_t)l * FF * DM; K = FF; N = DM; WT = (bf16_t*)(wl + WO_D1); }
            else if ((r -= IT_D) < IT_D) { W = a.in[I_F2D] + (size_t)l * FF * DM; K = FF; N = DM; WT = (bf16_t*)(wl + WO_D2); }
            else if ((r -= IT_D) < IT_IN) { W = a.in[I_WIN] + (size_t)l * DM * INW; K = DM; N = INW; WT = (bf16_t*)(wl + WO_IN); }
            else { r -= IT_IN; W = a.in[I_WOUT] + (size_t)l * DM * DM; K = DM; N = DM; WT = (bf16_t*)(wl + WO_OUT); }
            const int nblk = N / 32, kb = r / nblk, nb = r % nblk, n0 = 32 * nb;
            int drow0 = n0;
            if (gu) { const int j = (n0 < FF) ? n0 : n0 - FF; drow0 = (j >> 7) * 256 + ((n0 < FF) ? 0 : 128) + (j & 127); }
            transpose_item(W, K, N, WT, 64 * kb, n0, drow0, scr, F.lane);
        }
    }
}

#undef a
__device__ __forceinline__ void phase_norm(int l, int ishift, int nrows) {
    const KArgs ap = get_args(); Ctx F = make_ctx(ap);
    const float* MOD = (const float*)(F.ws + WS_MOD) + (size_t)l * 3 * MODW;
    const float* X = (const float*)(F.ws + WS_X); bf16_t* XN = (bf16_t*)(F.ws + WS_XN);
    for (int row = F.gw; row < nrows; row += F.NGW) {
        const int grp = row < SEQ ? 0 : (row < ML ? 1 : 2);
        const f32x4* xr = (const f32x4*)(X + (size_t)row * DM) + F.lane;
        f32x4 v[8]; float s = 0.f;
#pragma unroll
        for (int j = 0; j < 8; ++j) { v[j] = xr[64 * j]; s += (v[j].x * v[j].x + v[j].y * v[j].y) + (v[j].z * v[j].z + v[j].w * v[j].w); }
        const float rstd = rsqrtf(wave_sum(s) * (1.f / DM) + RMS_EPS);
        const f32x4* sh = (const f32x4*)(MOD + (size_t)grp * MODW + ishift * DM) + F.lane;
        const f32x4* sc = (const f32x4*)(MOD + (size_t)grp * MODW + (ishift + 1) * DM) + F.lane;
        u32x2* o = (u32x2*)(XN + (size_t)row * DM) + F.lane;
#pragma unroll
        for (int j = 0; j < 8; ++j) { const f32x4 y = v[j] * rstd * (sc[64 * j] + 1.f) + sh[64 * j]; u32x2 w; w.x = cvt_pk_bf16(y.x, y.y); w.y = cvt_pk_bf16(y.z, y.w); o[64 * j] = w; }
    }
}

template <int HDIM>
__device__ __forceinline__ void qk_step(bf16_t* prow, int col0, const float* gain, bool rope, int prow_pos, int pcol_pos, int lane) {
    constexpr int LPH = HDIM / 4, LPHALF = HDIM / 8;
    const int hs = lane / LPH, u = lane % LPH, half = u / LPHALF, ip = u % LPHALF;
    const int a0 = half * (HDIM / 2) + 2 * ip, b0 = a0 + HDIM / 4;
    unsigned* pa = (unsigned*)(prow + col0 + hs * HDIM + a0); unsigned* pb = (unsigned*)(prow + col0 + hs * HDIM + b0);
    const unsigned ua = *pa, ub = *pb;
    float xa0 = bf_lo(ua), xa1 = bf_hi(ua), xb0 = bf_lo(ub), xb1 = bf_hi(ub);
    float ss = xa0 * xa0 + xa1 * xa1 + xb0 * xb0 + xb1 * xb1;
    ss = group_sum<LPH>(ss);
    const float rstd = rsqrtf(ss * (1.f / HDIM) + RMS_EPS);
    xa0 *= rstd * gain[a0]; xa1 *= rstd * gain[a0 + 1]; xb0 *= rstd * gain[b0]; xb1 *= rstd * gain[b0 + 1];
    if (rope) {
        const float pos = (float)(half ? pcol_pos : prow_pos);
        constexpr float L2T = 13.287712379549449f;
        const float f0 = exp2f(-(float)(2 * ip) * (L2T / (HDIM / 4))), f1 = exp2f(-(float)(2 * ip + 1) * (L2T / (HDIM / 4)));
        float s0, c0, s1, c1; sincos_small(pos * f0, s0, c0); sincos_small(pos * f1, s1, c1);
        const float ya0 = xa0 * c0 - xb0 * s0, yb0 = xa0 * s0 + xb0 * c0, ya1 = xa1 * c1 - xb1 * s1, yb1 = xa1 * s1 + xb1 * c1;
        xa0 = ya0; xb0 = yb0; xa1 = ya1; xb1 = yb1;
    }
    *pa = cvt_pk_bf16(xa0, xa1); *pb = cvt_pk_bf16(xb0, xb1);
}
__device__ __forceinline__ void phase_qk(int l) {
    const KArgs ap = get_args(); Ctx F = make_ctx(ap);
#define a (*ap)
    bf16_t* P = (bf16_t*)(F.ws + WS_P);
    const float* aqg = a.in[I_AQG] + l * 128; const float* akg = a.in[I_AKG] + l * 128;
    const float* bqg = a.in[I_BQG] + l * 64;  const float* bkg = a.in[I_BKG] + l * 64;
    const float* cqg = a.in[I_CQG] + l * 128; const float* ckg = a.in[I_CKG] + l * 128;
    for (int row = F.gw; row < MT; row += F.NGW) {
        bf16_t* pr = P + (size_t)row * INW;
        const bool lat = row < ML; const int t = row & (SEQ - 1), rr = t >> 6, cc = t & 63;
#pragma unroll 1
        for (int s = 0; s < 3; ++s) qk_step<128>(pr, OFF_AQ + s * 256, aqg, lat, rr, cc, F.lane);
        qk_step<128>(pr, OFF_AK, akg, lat, rr, cc, F.lane);
#pragma unroll 1
        for (int s = 0; s < 2; ++s) qk_step<64>(pr, OFF_BQ + s * 256, bqg, lat, rr, cc, F.lane);
#pragma unroll 1
        for (int s = 0; s < 2; ++s) qk_step<64>(pr, OFF_BK + s * 256, bkg, lat, rr, cc, F.lane);
#pragma unroll 1
        for (int s = 0; s < 3; ++s) qk_step<128>(pr, OFF_CQ + s * 256, cqg, false, rr, cc, F.lane);
#pragma unroll 1
        for (int s = 0; s < 3; ++s) qk_step<128>(pr, OFF_CK + s * 256, ckg, false, rr, cc, F.lane);
    }
}

#undef a
struct NaiveAcc { float m, l, o0, o1; };
__device__ __forceinline__ void naive_key(NaiveAcc& A, const bf16_t* P, int krow, int kcol, int vcol, float q0, float q1, float scale, float bias, int lane) {
    const unsigned kk = *(const unsigned*)(P + (size_t)krow * INW + kcol + 2 * lane);
    const float s = wave_sum(q0 * bf_lo(kk) + q1 * bf_hi(kk)) * scale + bias;
    const float mn = fmaxf(A.m, s), al = __expf(A.m - mn), p = __expf(s - mn);
    const unsigned vv = *(const unsigned*)(P + (size_t)krow * INW + vcol + 2 * lane);
    A.l = A.l * al + p; A.o0 = A.o0 * al + p * bf_lo(vv); A.o1 = A.o1 * al + p * bf_hi(vv); A.m = mn;
}
__device__ __forceinline__ void phase_attn_naive(int l, bool with_ctx) {
    const KArgs ap = get_args(); Ctx F = make_ctx(ap);
#define a (*ap)
    const bf16_t* P = (const bf16_t*)(F.ws + WS_P); bf16_t* AO = (bf16_t*)(F.ws + WS_AO);
    const float lam = ((const float*)(F.ws + WS_SCAL))[l];
    const int nrows = with_ctx ? MT : ML;
    const int nitems = nrows * 16;
    for (int it = F.gw; it < nitems; it += F.NGW) {
        int row, hd;
        if (it < ML * 16) { const int b = it / (SEQ * 16), r = it % (SEQ * 16); hd = r / SEQ; row = b * SEQ + r % SEQ; }
        else { const int r0 = it - ML * 16; const int b = r0 / (CTX * 16), r = r0 % (CTX * 16); hd = r / CTX; row = ML + b * CTX + r % CTX; }
        const bool lat = row < ML; const int b = lat ? row / SEQ : (row - ML) / CTX;
        const int t = row & (SEQ - 1), qr = t >> 6, qc = t & 63;
        const int ctx0 = ML + b * CTX, lat0 = b * SEQ;
        float o0, o1;
        if (hd < 6 || hd >= 10) {
            const bool isC = hd >= 10; const int h = isC ? hd - 10 : hd;
            const int qcol = isC ? OFF_CQ + h * 128 : OFF_AQ + h * 128;
            const int kcol = isC ? OFF_CK + h * 128 : OFF_AK + (h / 3) * 128;
            const int vcol = isC ? OFF_CV + h * 128 : OFF_AV + (h / 3) * 128;
            const unsigned qq = *(const unsigned*)(P + (size_t)row * INW + qcol + 2 * F.lane);
            const float q0 = bf_lo(qq), q1 = bf_hi(qq); const float scale = 0.08838834764831845f;
            NaiveAcc A{-1e30f, 0.f, 0.f, 0.f};
            for (int i = 0; i < CTX; ++i) naive_key(A, P, ctx0 + i, kcol, vcol, q0, q1, scale, 0.f, F.lane);
            if (lat) {
                if (!isC) { for (int i = 0; i < SEQ; ++i) naive_key(A, P, lat0 + i, kcol, vcol, q0, q1, scale, 0.f, F.lane); }
                else {
                    const int rs = min(max(qr - 4, 0), 56), cs = min(max(qc - 8, 0), 48);
                    const float* rb = a.in[I_CRB] + ((size_t)l * 6 + h) * 15 * 31;
                    for (int w = 0; w < 128; ++w) { const int kr = rs + (w >> 4), kc = cs + (w & 15);
                        naive_key(A, P, lat0 + kr * 64 + kc, kcol, vcol, q0, q1, scale, rb[(kr - qr + 7) * 31 + (kc - qc + 15)], F.lane); }
                }
            }
            const float il = 1.f / A.l; o0 = A.o0 * il; o1 = A.o1 * il;
        } else {
            const int h = hd - 6; const int vcol = OFF_BV + h * 128; const float scale = 0.125f;
            float r0[2], r1[2];
#pragma unroll 1
            for (int sub = 0; sub < 2; ++sub) {
                const int qcol = OFF_BQ + h * 128 + sub * 64, kcol = OFF_BK + h * 128 + sub * 64;
                const unsigned qq = *(const unsigned*)(P + (size_t)row * INW + qcol + 2 * F.lane);
                const float q0 = F.lane < 32 ? bf_lo(qq) : 0.f, q1 = F.lane < 32 ? bf_hi(qq) : 0.f;
                NaiveAcc A{-1e30f, 0.f, 0.f, 0.f};
                for (int i = 0; i < CTX; ++i) naive_key(A, P, ctx0 + i, kcol, vcol, q0, q1, scale, 0.f, F.lane);
                if (lat) for (int i = 0; i < SEQ; ++i) naive_key(A, P, lat0 + i, kcol, vcol, q0, q1, scale, 0.f, F.lane);
                const float il = 1.f / A.l; r0[sub] = A.o0 * il; r1[sub] = A.o1 * il;
            }
            o0 = r0[0] - lam * r0[1]; o1 = r1[0] - lam * r1[1];
        }
        *(unsigned*)(AO + (size_t)row * DM + hd * 128 + 2 * F.lane) = cvt_pk_bf16(o0, o1);
    }
}

#undef a
namespace fa {
using f32x16 = __attribute__((ext_vector_type(16))) float;
using s16x4 = __attribute__((ext_vector_type(4))) short;
constexpr int D = 128, NW = 8, QBLK = 32, KVBLK = 64, LDK = INW;
constexpr int SHM_V = KVBLK * D * 2, SHM_K = KVBLK * D * 2;
constexpr int OFF_WS = 2 * SHM_V + 2 * SHM_K, OFF_BIAS = OFF_WS + NW * 64 * 4, OFF_UNIT = OFF_BIAS + 2048;
constexpr float THR = 8.f, NEG = -1e30f;
#define KSWZ(row, colB) ((row) * 256 + ((colB) ^ (((row) & 7) << 4)))
#define SBAR() __builtin_amdgcn_sched_barrier(0)
__device__ __forceinline__ int crow(int r, int hi) { return (r & 3) + 8 * (r >> 2) + 4 * hi; }

template <int MODE> struct Sc { static constexpr float SCALE = (MODE == 1) ? 0.125f : 0.088388347648318440f; };

template <int MODE>
__device__ __forceinline__ void partialSM(f32x16& p0, f32x16& p1, float& m_reg, float& mn, float& alpha) {
  constexpr float SCALE = Sc<MODE>::SCALE, C = SCALE * 1.4426950408889634f;
  float pmax = p0[0];
#pragma unroll
  for (int r = 1; r < 16; ++r) pmax = fmaxf(pmax, p0[r]);
#pragma unroll
  for (int r = 0; r < 16; ++r) pmax = fmaxf(pmax, p1[r]);
  { auto rr = __builtin_amdgcn_permlane32_swap(__float_as_uint(pmax), __float_as_uint(pmax), false, false);
    pmax = fmaxf(__uint_as_float(rr[0]), __uint_as_float(rr[1])); }
  if (__builtin_expect(__all(pmax - m_reg <= THR / SCALE), 1)) { mn = m_reg; alpha = 1.f; }
  else { mn = fmaxf(m_reg, pmax); alpha = __builtin_amdgcn_exp2f((m_reg - mn) * C); m_reg = mn; }
  const float mnC = -mn * C;
#pragma unroll
  for (int r = 0; r < 16; ++r) p0[r] = fmaf(p0[r], C, mnC);
#pragma unroll
  for (int r = 0; r < 16; ++r) p1[r] = fmaf(p1[r], C, mnC);
#pragma unroll
  for (int r = 0; r < 16; ++r) p0[r] = __builtin_amdgcn_exp2f(p0[r]);
}
__device__ __forceinline__ void finishSM(f32x16& p0, f32x16& p1, float alpha, float& l_reg, bf16x8& pa0, bf16x8& pa1, bf16x8& pa2, bf16x8& pa3) {
#pragma unroll
  for (int r = 0; r < 16; ++r) p1[r] = __builtin_amdgcn_exp2f(p1[r]);
  float ps = 0;
#pragma unroll
  for (int r = 0; r < 16; ++r) ps += p0[r];
#pragma unroll
  for (int r = 0; r < 16; ++r) ps += p1[r];
  { auto rr = __builtin_amdgcn_permlane32_swap(__float_as_uint(ps), __float_as_uint(ps), false, false);
    ps = __uint_as_float(rr[0]) + __uint_as_float(rr[1]); }
  l_reg = l_reg * alpha + ps;
#define PK4(P, BASE, OUT) do { unsigned a0 = cvt_pk_bf16(P[BASE + 0], P[BASE + 1]), a1 = cvt_pk_bf16(P[BASE + 2], P[BASE + 3]);   \
    unsigned b0 = cvt_pk_bf16(P[BASE + 4], P[BASE + 5]), b1 = cvt_pk_bf16(P[BASE + 6], P[BASE + 7]);                              \
    auto r0 = __builtin_amdgcn_permlane32_swap(a0, b0, false, false); auto r1 = __builtin_amdgcn_permlane32_swap(a1, b1, false, false); \
    u32x4 w = {r0[0], r1[0], r0[1], r1[1]}; OUT = *reinterpret_cast<bf16x8*>(&w); } while (0)
  PK4(p0, 0, pa0); PK4(p0, 8, pa1); PK4(p1, 0, pa2); PK4(p1, 8, pa3);
#undef PK4
}
template <int ND0>
__device__ __forceinline__ void qkt(f32x16& p0, f32x16& p1, const char* Ks, const bf16x8* qr, int r32, int hi, int kcb) {
  p0 = f32x16{}; p1 = f32x16{};
#pragma unroll
  for (int d0 = 0; d0 < ND0; ++d0) { const int cb = kcb + (d0 * 16 + hi * 8) * 2;
    const bf16x8 b0 = *reinterpret_cast<const bf16x8*>(Ks + KSWZ(r32, cb));
    const bf16x8 b1 = *reinterpret_cast<const bf16x8*>(Ks + KSWZ(32 + r32, cb));
    p0 = __builtin_amdgcn_mfma_f32_32x32x16_bf16(b0, qr[d0], p0, 0, 0, 0);
    p1 = __builtin_amdgcn_mfma_f32_32x32x16_bf16(b1, qr[d0], p1, 0, 0, 0); }
}
__device__ __forceinline__ int v_st(int k, int c) { const int kk = (k & ~0xC) | ((k & 4) << 1) | ((k & 8) >> 1); return ((kk >> 3) * 4 + (c >> 5)) * 512 + ((kk & 7) * 32 + (c & 31)) * 2; }
__device__ __forceinline__ int v_rd_base(int lane) { return ((lane & 3) << 3) | (((lane >> 2) & 3) << 6) | (((lane >> 4) & 1) << 5) | (((lane >> 5) & 1) << 8); }
constexpr int v_rd_off(int d0, int ks, int half) { return d0 * 512 + ks * 4096 + half * 2048; }
template <int OFF> __device__ __forceinline__ s16x4 tr_read(int vb) {
  s16x4 r; asm volatile("ds_read_b64_tr_b16 %0, %1 offset:%2" : "=&v"(r) : "v"(vb), "i"(OFF) : "memory"); return r;
}
template <int D0> __device__ __forceinline__ void pv_one(f32x16& od, int vb, bf16x8 pa0, bf16x8 pa1, bf16x8 pa2, bf16x8 pa3) {
  const s16x4 l0 = tr_read<v_rd_off(D0, 0, 0)>(vb), h0 = tr_read<v_rd_off(D0, 0, 1)>(vb), l1 = tr_read<v_rd_off(D0, 1, 0)>(vb), h1 = tr_read<v_rd_off(D0, 1, 1)>(vb);
  const s16x4 l2 = tr_read<v_rd_off(D0, 2, 0)>(vb), h2 = tr_read<v_rd_off(D0, 2, 1)>(vb), l3 = tr_read<v_rd_off(D0, 3, 0)>(vb), h3 = tr_read<v_rd_off(D0, 3, 1)>(vb);
  asm volatile("s_waitcnt lgkmcnt(0)" ::: "memory"); SBAR();
#define PK(L, H) (bf16x8){L[0], L[1], L[2], L[3], H[0], H[1], H[2], H[3]}
  od = __builtin_amdgcn_mfma_f32_32x32x16_bf16(pa0, PK(l0, h0), od, 0, 0, 0);
  od = __builtin_amdgcn_mfma_f32_32x32x16_bf16(pa1, PK(l1, h1), od, 0, 0, 0);
  od = __builtin_amdgcn_mfma_f32_32x32x16_bf16(pa2, PK(l2, h2), od, 0, 0, 0);
  od = __builtin_amdgcn_mfma_f32_32x32x16_bf16(pa3, PK(l3, h3), od, 0, 0, 0);
#undef PK
}
__device__ __forceinline__ void pv_d0(f32x16* o, int vb, bf16x8 pa0, bf16x8 pa1, bf16x8 pa2, bf16x8 pa3) {
  pv_one<0>(o[0], vb, pa0, pa1, pa2, pa3); pv_one<1>(o[1], vb, pa0, pa1, pa2, pa3); pv_one<2>(o[2], vb, pa0, pa1, pa2, pa3); pv_one<3>(o[3], vb, pa0, pa1, pa2, pa3);
}
__device__ __forceinline__ void cmask(f32x16& p0, f32x16& p1, int kr, int qrow, int qcol, int hi, const float* bias) {
  const int rs = min(max(qrow - 4, 0), 56);
  if (kr < rs || kr >= rs + 8) {
#pragma unroll
    for (int r = 0; r < 16; ++r) { p0[r] = NEG; p1[r] = NEG; }
    return;
  }
  const int cs = min(max(qcol - 8, 0), 48);
  const float* brow = bias + (kr - qrow + 7) * 31 + (15 - qcol);
#pragma unroll
  for (int r = 0; r < 16; ++r) { const int kc = crow(r, hi);
    p0[r] = ((unsigned)(kc - cs) < 16u) ? p0[r] + brow[kc] : NEG;
    p1[r] = ((unsigned)(kc + 32 - cs) < 16u) ? p1[r] + brow[kc + 32] : NEG; }
}

struct Unit { int qrow0, qcol, kcol, vcol, ocol, seg0, seg1, NT, r0, win; float lam; };

template <int MODE>
__device__ __forceinline__ void attn_unit(const bf16_t* __restrict__ P, bf16_t* __restrict__ AO, const Unit u, char* lds) {
  constexpr int ND0 = (MODE == 1) ? 4 : 8;
  int tid = threadIdx.x; asm volatile("" : "+v"(tid));
  const int wid = __builtin_amdgcn_readfirstlane(tid >> 6), lane = tid & 63, r32 = lane & 31, hi = lane >> 5;
  const int sub = (MODE == 1) ? (wid >> 2) : 0, wq = (MODE == 1) ? (wid & 3) : wid;
  char* V_lds = lds; char* K_lds = lds + 2 * SHM_V;
  float* wsf = (float*)(lds + OFF_WS) + wid * 64; float* li_l = wsf; float* al_l = wsf + 32;
  const float* bias = (const float*)(lds + OFF_BIAS);
  float m_reg = NEG, l_reg = 0; f32x16 o[4] = {}; bf16x8 qr[ND0];
  const bf16_t* Qw = P + (size_t)(u.qrow0 + wq * QBLK + r32) * INW + u.qcol + sub * 64 + hi * 8;
#pragma unroll
  for (int d0 = 0; d0 < ND0; ++d0) qr[d0] = *reinterpret_cast<const bf16x8*>(Qw + d0 * 16);
  const int kcb = sub * 128;
  const int sr = tid >> 4, sc = (tid & 15) * 8, vst0 = v_st(sr, sc), vst1 = v_st(32 + sr, sc);
  const int vb0 = (int)(uintptr_t)V_lds + v_rd_base(lane);
  const unsigned kgo = (unsigned)((sr * INW + u.kcol + sc) * 2), vgo = (unsigned)((sr * INW + u.vcol + sc) * 2);
  constexpr int SD = (MODE == 2) ? 1 : 2;
  struct { bf16x8 vs0, vs1, ks0, ks1; } sr_[SD];
#define TROW(t) ((size_t)((t) < 4 ? u.seg0 + 64 * (t) : u.seg1 + 64 * ((t) - 4)) * (INW * 2))
#define SLOAD(i, t) do { const char* tb_ = (const char*)P + TROW(t); sr_[i].vs0 = *reinterpret_cast<const bf16x8*>(tb_ + vgo); sr_[i].vs1 = *reinterpret_cast<const bf16x8*>(tb_ + 32 * INW * 2 + vgo); \
    sr_[i].ks0 = *reinterpret_cast<const bf16x8*>(tb_ + kgo); sr_[i].ks1 = *reinterpret_cast<const bf16x8*>(tb_ + 32 * INW * 2 + kgo); } while (0)
#define SWRITE(b, i) do { *(bf16x8*)(V_lds + (b) * SHM_V + vst0) = sr_[i].vs0; *(bf16x8*)(V_lds + (b) * SHM_V + vst1) = sr_[i].vs1; const int kc = sc * 2; \
    *(bf16x8*)(K_lds + (b) * SHM_K + KSWZ(sr, kc)) = sr_[i].ks0; *(bf16x8*)(K_lds + (b) * SHM_K + KSWZ(32 + sr, kc)) = sr_[i].ks1; } while (0)
#define SWAIT() do { if (SD == 2) asm volatile("s_waitcnt vmcnt(4)" ::: "memory"); else asm volatile("s_waitcnt vmcnt(0)" ::: "memory"); } while (0)
#define RESC(a) do { if (__any((a) < 1.f)) { if (hi == 0) al_l[r32] = (a); asm volatile("s_waitcnt lgkmcnt(0)" ::: "memory"); \
    _Pragma("unroll") for (int d = 0; d < 4; ++d) _Pragma("unroll") for (int r = 0; r < 16; ++r) o[d][r] *= al_l[crow(r, hi)]; } } while (0)
  const int qrow_g = u.r0 + (wid >> 1), qcol_g = 32 * (wid & 1) + r32;
#define CM(P0, P1, t) do { if (MODE == 2 && u.win && (t) >= 4) cmask(P0, P1, u.seg1 / 64 % 64 + (t) - 4, qrow_g, qcol_g, hi, bias); } while (0)
  f32x16 pA0, pA1, pB0, pB1; float mnA, mnB, alA, alB; bf16x8 pa0, pa1, pa2, pa3; const int NT = u.NT;
  constexpr int SE = 0, SO = SD - 1;
  SLOAD(SE, 0); asm volatile("s_waitcnt vmcnt(0)" ::: "memory"); SWRITE(0, SE); __syncthreads();
  qkt<ND0>(pA0, pA1, K_lds, qr, r32, hi, kcb); partialSM<MODE>(pA0, pA1, m_reg, mnA, alA);
  SLOAD(SO, 1); if (SD == 2 && 2 < NT) SLOAD(SE, 2);
  SWAIT(); SWRITE(1, SO); __syncthreads();
  for (int j = 1; j + 1 < NT; j += 2) {
    SBAR(); qkt<ND0>(pB0, pB1, K_lds + SHM_K, qr, r32, hi, kcb);
    finishSM(pA0, pA1, alA, l_reg, pa0, pa1, pa2, pa3); SBAR();
    SLOAD(SO, j + SD); SBAR();
    pv_d0(o, vb0, pa0, pa1, pa2, pa3); CM(pB0, pB1, j); partialSM<MODE>(pB0, pB1, m_reg, mnB, alB);
    __syncthreads(); SWAIT(); SWRITE(0, SE);
    RESC(alB); __syncthreads();
    SBAR(); qkt<ND0>(pA0, pA1, K_lds, qr, r32, hi, kcb);
    finishSM(pB0, pB1, alB, l_reg, pa0, pa1, pa2, pa3); SBAR();
    if (SD == 1 || j + 3 < NT) SLOAD(SE, j + 1 + SD); SBAR();
    pv_d0(o, vb0 + SHM_V, pa0, pa1, pa2, pa3); CM(pA0, pA1, j + 1); partialSM<MODE>(pA0, pA1, m_reg, mnA, alA);
    __syncthreads(); SWAIT(); SWRITE(1, SO);
    RESC(alA); __syncthreads();
  }
  SBAR(); qkt<ND0>(pB0, pB1, K_lds + SHM_K, qr, r32, hi, kcb);
  finishSM(pA0, pA1, alA, l_reg, pa0, pa1, pa2, pa3); SBAR();
  pv_d0(o, vb0, pa0, pa1, pa2, pa3); CM(pB0, pB1, NT - 1); partialSM<MODE>(pB0, pB1, m_reg, mnB, alB);
  __syncthreads(); RESC(alB);
  finishSM(pB0, pB1, alB, l_reg, pa0, pa1, pa2, pa3); SBAR();
  pv_d0(o, vb0 + SHM_V, pa0, pa1, pa2, pa3);
  if (hi == 0) li_l[r32] = l_reg; asm volatile("s_waitcnt lgkmcnt(0)" ::: "memory");
  float rli[16];
#pragma unroll
  for (int r = 0; r < 16; ++r) rli[r] = __builtin_amdgcn_rcpf(li_l[crow(r, hi)]);
  bf16_t* Ow = AO + (size_t)(u.qrow0 + wq * QBLK) * DM + u.ocol;
  if (MODE == 1) {
    float* X = (float*)lds;
    __syncthreads();
    if (sub == 1) {
#pragma unroll
      for (int d0 = 0; d0 < 4; ++d0)
#pragma unroll
        for (int r = 0; r < 16; ++r) X[((d0 * 16 + r) * 4 + wq) * 64 + lane] = o[d0][r] * rli[r];
    }
    __syncthreads();
    if (sub == 0) {
#pragma unroll
      for (int r = 0; r < 16; ++r) { const int orow = crow(r, hi);
#pragma unroll
        for (int d0 = 0; d0 < 4; ++d0) { const float v = o[d0][r] * rli[r] - u.lam * X[((d0 * 16 + r) * 4 + wq) * 64 + lane];
          Ow[(size_t)orow * DM + d0 * 32 + r32] = (bf16_t)(cvt_pk_bf16(v, 0.f) & 0xffffu); } }
    }
  } else {
#pragma unroll
    for (int r = 0; r < 16; ++r) { const int orow = crow(r, hi);
#pragma unroll
      for (int d0 = 0; d0 < 4; ++d0) Ow[(size_t)orow * DM + d0 * 32 + r32] = (bf16_t)(cvt_pk_bf16(o[d0][r] * rli[r], 0.f) & 0xffffu); }
  }
#undef TROW
#undef SLOAD
#undef SWRITE
#undef SWAIT
#undef RESC
#undef CM
}
#undef KSWZ
#undef SBAR
}

__device__ __forceinline__ void phase_attn(int l, bool with_ctx) {
    const KArgs ap = get_args(); Ctx F = make_ctx(ap);
    const bf16_t* P = (const bf16_t*)(F.ws + WS_P); bf16_t* AO = (bf16_t*)(F.ws + WS_AO);
    unsigned* ctr = (unsigned*)(F.ws + WS_CTL) + 64 * l;
    const float lam = ((const float*)(F.ws + WS_SCAL))[l];
    char* lds = (char*)lds_raw;
    volatile unsigned* uw = (volatile unsigned*)(lds + fa::OFF_UNIT);
    const int NU = with_ctx ? 680 : 640;
    for (;;) {
        __syncthreads();
        if (F.tid == 0) *uw = atomicAdd(ctr, 1u);
        __syncthreads();
        const int un = (int)*uw;
        if (un >= NU) break;
        fa::Unit u; u.lam = lam; u.win = 0; u.r0 = 0; u.seg1 = 0;
        if (un < 192) {
            const int b = un / 96, h = (un % 96) / 16, qb = un % 16;
            u.qrow0 = b * SEQ + qb * 256; u.qcol = OFF_AQ + h * 128; u.kcol = OFF_AK + (h / 3) * 128; u.vcol = OFF_AV + (h / 3) * 128; u.ocol = h * 128;
            u.seg0 = ML + b * CTX; u.seg1 = b * SEQ; u.NT = 68;
            fa::attn_unit<0>(P, AO, u, lds);
        } else if (un < 448) {
            const int v = un - 192, b = v / 128, h = (v % 128) / 32, qb = v % 32;
            u.qrow0 = b * SEQ + qb * 128; u.qcol = OFF_BQ + h * 128; u.kcol = OFF_BK + h * 128; u.vcol = OFF_BV + h * 128; u.ocol = 768 + h * 128;
            u.seg0 = ML + b * CTX; u.seg1 = b * SEQ; u.NT = 68;
            fa::attn_unit<1>(P, AO, u, lds);
        } else if (un < 640) {
            const int v = un - 448, b = v / 96, h = (v % 96) / 16, qb = v % 16;
            const int r0 = qb * 4, rbase = min(max(r0 - 4, 0), 52);
            u.qrow0 = b * SEQ + qb * 256; u.qcol = OFF_CQ + h * 128; u.kcol = OFF_CK + h * 128; u.vcol = OFF_CV + h * 128; u.ocol = 1280 + h * 128;
            u.seg0 = ML + b * CTX; u.seg1 = b * SEQ + rbase * 64; u.NT = 16; u.r0 = r0; u.win = 1;
            { const float* rb = ap->in[I_CRB] + ((size_t)l * 6 + h) * 465; float* bl = (float*)(lds + fa::OFF_BIAS);
              if (F.tid < 465) bl[F.tid] = rb[F.tid] * 11.313708498984761f; }
            fa::attn_unit<2>(P, AO, u, lds);
        } else {
            const int v = un - 640;
            u.NT = 4;
            if (v < 12) { const int b = v / 6, h = v % 6;
                u.qrow0 = ML + b * CTX; u.qcol = OFF_AQ + h * 128; u.kcol = OFF_AK + (h / 3) * 128; u.vcol = OFF_AV + (h / 3) * 128; u.ocol = h * 128; u.seg0 = ML + b * CTX;
                fa::attn_unit<0>(P, AO, u, lds);
            } else if (v < 28) { const int w = v - 12, b = w / 8, h = (w % 8) / 2, qb = w % 2;
                u.qrow0 = ML + b * CTX + qb * 128; u.qcol = OFF_BQ + h * 128; u.kcol = OFF_BK + h * 128; u.vcol = OFF_BV + h * 128; u.ocol = 768 + h * 128; u.seg0 = ML + b * CTX;
                fa::attn_unit<1>(P, AO, u, lds);
            } else { const int w = v - 28, b = w / 6, h = w % 6;
                u.qrow0 = ML + b * CTX; u.qcol = OFF_CQ + h * 128; u.kcol = OFF_CK + h * 128; u.vcol = OFF_CV + h * 128; u.ocol = 1280 + h * 128; u.seg0 = ML + b * CTX;
                fa::attn_unit<0>(P, AO, u, lds);
            }
        }
    }
}

__device__ __forceinline__ void phase_n3(int l, int nrows) {
    const KArgs ap = get_args(); Ctx F = make_ctx(ap);
#define a (*ap)
    bf16_t* AO = (bf16_t*)(F.ws + WS_AO);
    const float* ag = a.in[I_AOG] + l * 768; const float* bg = a.in[I_BOG] + l * 128; const float* cgn = a.in[I_COG] + l * 768;
    const float bmul = 1.f - ((l == 0) ? 0.2f : 0.35550906f);
    for (int row = F.gw; row < nrows; row += F.NGW) {
        u32x4* pr = (u32x4*)(AO + (size_t)row * DM) + F.lane;
        float v[4][8]; float ss[4];
#pragma unroll
        for (int j = 0; j < 4; ++j) { const u32x4 w = pr[64 * j];
            v[j][0] = bf_lo(w.x); v[j][1] = bf_hi(w.x); v[j][2] = bf_lo(w.y); v[j][3] = bf_hi(w.y); v[j][4] = bf_lo(w.z); v[j][5] = bf_hi(w.z); v[j][6] = bf_lo(w.w); v[j][7] = bf_hi(w.w);
            float s = 0.f;
#pragma unroll
            for (int e = 0; e < 8; ++e) s += v[j][e] * v[j][e];
            ss[j] = s; }
        const bool lo = F.lane < 32;
        const float sa = wave_sum(ss[0] + (lo ? ss[1] : 0.f));
        const float sc = wave_sum(ss[3] + (lo ? 0.f : ss[2]));
        float sb = lo ? ss[2] : ss[1];
        sb = group_sum<16>(sb);
        const float ra = rsqrtf(sa * (1.f / 768.f) + RMS_EPS), rc = rsqrtf(sc * (1.f / 768.f) + RMS_EPS), rb = rsqrtf(sb * (1.f / 128.f) + RMS_EPS) * bmul;
#pragma unroll
        for (int j = 0; j < 4; ++j) {
            const int col = j * 512 + F.lane * 8;
            float r; const float* gp;
            if (col < 768) { r = ra; gp = ag + col; } else if (col < 1280) { r = rb; gp = bg + ((col - 768) & 127); } else { r = rc; gp = cgn + (col - 1280); }
            const f32x4 g0 = *(const f32x4*)gp, g1 = *(const f32x4*)(gp + 4);
            u32x4 w; w.x = cvt_pk_bf16(v[j][0] * r * g0.x, v[j][1] * r * g0.y); w.y = cvt_pk_bf16(v[j][2] * r * g0.z, v[j][3] * r * g0.w);
            w.z = cvt_pk_bf16(v[j][4] * r * g1.x, v[j][5] * r * g1.y); w.w = cvt_pk_bf16(v[j][6] * r * g1.z, v[j][7] * r * g1.w);
            pr[64 * j] = w;
        }
    }
}

#undef a
constexpr int N_PHASES = 1 + 12 * DEPTH;

#define PH_IN(k) (lo <= (k) && (k) < hi)
#define PH_SYNC(k) do { if (coop && (k) + 1 < hi) cg::this_grid().sync(); } while (0)
template <int L>
__device__ __forceinline__ void layer_phases(LAS unsigned char* lds, unsigned char* ws, float* out, int lo, int hi, int coop) {
    constexpr bool last = (L == DEPTH - 1);
    constexpr int mrows_tail = last ? ML : MT;
    constexpr int P0 = 1 + 12 * L;
    unsigned char* wl = ws + WS_W + (size_t)L * WL_STRIDE;
    const float* MOD = (const float*)(ws + WS_MOD) + (size_t)L * 3 * MODW;
    const int G = (int)gridDim.x, bid = (int)blockIdx.x;
    if (PH_IN(P0 + 0)) { phase_norm(L, 0, MT); PH_SYNC(P0 + 0); }
    if (PH_IN(P0 + 1)) {
        pg8::Gemm g{(const bf16_t*)(ws + WS_XN), (const bf16_t*)(wl + WO_GU1), MT, 2 * FF, DM};
        pg8::StaticOrder<MT, 2 * FF, DM> S; S.init(G, bid); pg8::EpiSwiglu E{(bf16_t*)(ws + WS_H), FF};
        pg8::gemm_phase(lds, g, S, E); PH_SYNC(P0 + 1); }
    if (PH_IN(P0 + 2)) {
        pg8::Gemm g{(const bf16_t*)(ws + WS_H), (const bf16_t*)(wl + WO_D1), MT, DM, FF};
        pg8::SplitTailOrder<ML, MT, DM, FF, 11> S; S.init(G, bid); pg8::EpiResid E{(const float*)(ws + WS_X), (float*)(ws + WS_X), MOD + 2 * DM, 0.5f};
        pg8::gemm_phase(lds, g, S, E); PH_SYNC(P0 + 2); }
    if (PH_IN(P0 + 3)) { phase_norm(L, 3, MT); PH_SYNC(P0 + 3); }
    if (PH_IN(P0 + 4)) {
        pg8::Gemm g{(const bf16_t*)(ws + WS_XN), (const bf16_t*)(wl + WO_IN), MT, INW, DM};
        pg8::StaticOrder<MT, INW, DM> S; S.init(G, bid); pg8::EpiBf16 E{(bf16_t*)(ws + WS_P), INW};
        pg8::gemm_phase(lds, g, S, E); PH_SYNC(P0 + 4); }
    if (PH_IN(P0 + 5)) { phase_qk(L); PH_SYNC(P0 + 5); }
    if (PH_IN(P0 + 6)) { phase_attn(L, !last); PH_SYNC(P0 + 6); }
    if (PH_IN(P0 + 7)) { phase_n3(L, mrows_tail); PH_SYNC(P0 + 7); }
    if (PH_IN(P0 + 8)) {
        pg8::Gemm g{(const bf16_t*)(ws + WS_AO), (const bf16_t*)(wl + WO_OUT), mrows_tail, DM, DM};
        pg8::SplitTailOrder<ML, mrows_tail, DM, DM, 8> S; S.init(G, bid); pg8::EpiResid E{(const float*)(ws + WS_X), (float*)(ws + WS_X), MOD + 5 * DM, 1.f};
        pg8::gemm_phase(lds, g, S, E); PH_SYNC(P0 + 8); }
    if (PH_IN(P0 + 9)) { phase_norm(L, 6, mrows_tail); PH_SYNC(P0 + 9); }
    if (PH_IN(P0 + 10)) {
        pg8::Gemm g{(const bf16_t*)(ws + WS_XN), (const bf16_t*)(wl + WO_GU2), mrows_tail, 2 * FF, DM};
        pg8::StaticOrder<mrows_tail, 2 * FF, DM> S; S.init(G, bid); pg8::EpiSwiglu E{(bf16_t*)(ws + WS_H), FF};
        pg8::gemm_phase(lds, g, S, E); PH_SYNC(P0 + 10); }
    if (PH_IN(P0 + 11)) {
        pg8::Gemm g{(const bf16_t*)(ws + WS_H), (const bf16_t*)(wl + WO_D2), mrows_tail, DM, FF};
        pg8::SplitTailOrder<ML, mrows_tail, DM, FF, 11> S; S.init(G, bid); pg8::EpiResid E{(const float*)(ws + WS_X), last ? out : (float*)(ws + WS_X), MOD + 8 * DM, 0.5f};
        pg8::gemm_phase(lds, g, S, E); PH_SYNC(P0 + 11); }
}

__global__ void __launch_bounds__(NTHR, 2) mega_fwd(Args args) {
    LAS unsigned char* lds = (LAS unsigned char*)lds_raw;
    unsigned char* ws = args.ws;
    const int lo = args.ph_lo, hi = args.ph_hi, coop = args.coop;
    if (PH_IN(0)) { phase_prologue(); PH_SYNC(0); }
    layer_phases<0>(lds, ws, args.out, lo, hi, coop);
    layer_phases<1>(lds, ws, args.out, lo, hi, coop);
}

extern "C" void kernel_launch(void* const* d_in, const int* in_sizes, int n_in, void* d_out, int out_size, void* d_ws, size_t ws_size, hipStream_t stream) {
    static int grid = 0;
    if (grid == 0) {
        if (n_in != 23 || out_size != ML * DM || ws_size < WS_END) { fprintf(stderr, "kernel_launch: unexpected shapes n_in %d out %d ws %zu\n", n_in, out_size, ws_size); grid = -1; return; }
        int dev = 0, cus = 0, per_cu = 0;
        hipGetDevice(&dev); hipDeviceGetAttribute(&cus, hipDeviceAttributeMultiprocessorCount, dev);
        hipFuncSetAttribute((const void*)mega_fwd, hipFuncAttributeMaxDynamicSharedMemorySize, LDS_BYTES);
        hipOccupancyMaxActiveBlocksPerMultiprocessor(&per_cu, (const void*)mega_fwd, NTHR, LDS_BYTES);
        if (per_cu < 1) per_cu = 1;
        grid = cus * 1;
        (void)hipGetLastError();
    }
    if (grid < 0) return;
    hipMemsetAsync((char*)d_ws + WS_CTL, 0, CTL_ZERO_BYTES, stream);
    Args a{};
    for (int i = 0; i < 23; ++i) a.in[i] = (const float*)d_in[i];
    a.out = (float*)d_out; a.ws = (unsigned char*)d_ws;
#if MK_MULTI
    for (int ph = 0; ph < N_PHASES; ++ph) { a.ph_lo = ph; a.ph_hi = ph + 1; a.coop = 0; hipLaunchKernelGGL(mega_fwd, dim3(grid), dim3(NTHR), LDS_BYTES, stream, a); }
#else
    a.ph_lo = 0; a.ph_hi = N_PHASES; a.coop = 1;
    void* kargs[] = {&a};
    hipError_t e = hipLaunchCooperativeKernel((const void*)mega_fwd, dim3(grid), dim3(NTHR), kargs, LDS_BYTES, stream);
    if (e != hipSuccess) fprintf(stderr, "cooperative launch failed: %s (grid %d)\n", hipGetErrorString(e), grid);
#endif
}
```

```cpp
#include <hip/hip_runtime.h>
#include <hip/hip_cooperative_groups.h>
#include <cstdio>
#include <cstdint>
namespace cg = cooperative_groups;

#ifndef DUP
#define DUP 0
#endif
#ifndef MK_MULTI
#define MK_MULTI 0
#endif

#define GAS __attribute__((address_space(1)))
#define LAS __attribute__((address_space(3)))
typedef unsigned short bf16_t;
typedef short bf16x8 __attribute__((ext_vector_type(8)));
typedef float f32x4 __attribute__((ext_vector_type(4)));
typedef float f32x2 __attribute__((ext_vector_type(2)));
typedef unsigned u32x4 __attribute__((ext_vector_type(4)));
typedef unsigned u32x2 __attribute__((ext_vector_type(2)));

constexpr int DM = 2048, BATCH = 2, SEQ = 4096, DEPTH = 2, GRIDW = 64, CTX = 256, NMOD = 9, FF = 5632;
constexpr int ML = BATCH * SEQ, MC = BATCH * CTX, MT = ML + MC;
constexpr int INW = 5120, MODW = NMOD * DM;
constexpr int OFF_AQ = 0, OFF_AK = 768, OFF_AV = 1024, OFF_BQ = 1280, OFF_BK = 1792, OFF_BV = 2304, OFF_CQ = 2816, OFF_CK = 3584, OFF_CV = 4352;
constexpr float RMS_EPS = 1e-6f;
constexpr int NWAVES = 8, NTHR = 512;

constexpr size_t MiB = 1u << 20;
constexpr size_t WS_CTL = 0, CTL_ZERO_BYTES = 1 * MiB;
constexpr size_t WS_MOD = 65536;
constexpr size_t WS_SCAL = 1 * MiB;
constexpr size_t WS_W = 2 * MiB, WL_STRIDE = 160 * MiB;
constexpr size_t WO_GU1 = 0, WO_D1 = 44 * MiB, WO_IN = 66 * MiB, WO_OUT = 86 * MiB, WO_GU2 = 94 * MiB, WO_D2 = 138 * MiB;
constexpr size_t WS_X = 322 * MiB;
constexpr size_t WS_XN = 390 * MiB;
constexpr size_t WS_H = 424 * MiB;
constexpr size_t WS_P = 518 * MiB;
constexpr size_t WS_AO = 604 * MiB;
constexpr size_t WS_PART = 640 * MiB;
constexpr size_t WS_END = 688 * MiB;
static_assert(WS_MOD + (size_t)DEPTH * 3 * MODW * 4 <= CTL_ZERO_BYTES, "mod inside zero region");
static_assert(WS_X + (size_t)MT * DM * 4 <= WS_XN && WS_XN + (size_t)MT * DM * 2 <= WS_H && WS_H + (size_t)MT * FF * 2 <= WS_P && WS_P + (size_t)MT * INW * 2 <= WS_AO && WS_AO + (size_t)MT * DM * 2 <= WS_END, "ws map");

constexpr int RING_BYTES = 131072, LDS_BYTES = 147456;

__device__ __forceinline__ unsigned cvt_pk_bf16(float lo, float hi) { unsigned r; asm volatile("v_cvt_pk_bf16_f32 %0, %1, %2" : "=v"(r) : "v"(lo), "v"(hi)); return r; }
__device__ __forceinline__ float bf_lo(unsigned u) { return __uint_as_float(u << 16); }
__device__ __forceinline__ float bf_hi(unsigned u) { return __uint_as_float(u & 0xffff0000u); }
template <int CTRL> __device__ __forceinline__ float dpp_f(float v) { return __uint_as_float((unsigned)__builtin_amdgcn_update_dpp(0, (int)__float_as_uint(v), CTRL, 0xf, 0xf, true)); }
template <int NL> __device__ __forceinline__ float group_sum(float v) {
    v += dpp_f<0xB1>(v);
    v += dpp_f<0x4E>(v);
    v += dpp_f<0x141>(v);
    v += dpp_f<0x140>(v);
    if (NL >= 32) v += __uint_as_float((unsigned)__builtin_amdgcn_ds_swizzle((int)__float_as_uint(v), 0x401F));
    if (NL >= 64) { auto rr = __builtin_amdgcn_permlane32_swap(__float_as_uint(v), __float_as_uint(v), false, false); v = __uint_as_float(rr[0]) + __uint_as_float(rr[1]); }
    return v;
}
__device__ __forceinline__ float wave_sum(float v) { return group_sum<64>(v); }
__device__ __forceinline__ float silu_f(float v) { return v / (1.f + __expf(-v)); }
__device__ __forceinline__ void sincos_small(float x, float& s, float& c) {
    const float k = rintf(x * 0.636619772f);
    float r = fmaf(-k, 1.57079637e+0f, x); r = fmaf(-k, -4.37113883e-8f, r);
    const float r2 = r * r;
    float sp = fmaf(r2, 2.7557319e-6f, -1.9841270e-4f); sp = fmaf(sp, r2, 8.3333333e-3f); sp = fmaf(sp, r2, -1.6666667e-1f); sp = fmaf(sp * r2, r, r);
    float cp = fmaf(r2, 2.4801587e-5f, -1.3888889e-3f); cp = fmaf(cp, r2, 4.1666667e-2f); cp = fmaf(cp, r2, -0.5f); cp = fmaf(cp, r2, 1.f);
    const int q = ((int)k) & 3;
    const float ss = (q & 1) ? cp : sp, cc = (q & 1) ? sp : cp;
    s = (q & 2) ? -ss : ss;
    c = ((q + 1) & 2) ? -cc : cc;
}

namespace pg8 {
constexpr int BM = 256, BK = 64, HALF = 128, HTB = HALF * BK * 2, STAGE_BYTES = 8 * HTB, NXCD = 8, WGM = 8;
__host__ __device__ __forceinline__ int lds_byte(int r, int c) { const int st = (r >> 4) * 2 + (c >> 5), rr = r & 15, cc = c & 31, ob = rr * 64 + cc * 2; return st * 1024 + (ob ^ (((ob >> 9) & 1) << 5)); }
__host__ __device__ __forceinline__ void stage_rc(int b, int& R, int& C) { const int st = b / 1024, sb = b % 1024, swz = sb ^ (((sb >> 9) & 1) << 5); R = (st >> 1) * 16 + swz / 64; C = (st & 1) * 32 + (swz % 64) / 2; }
__host__ __device__ __forceinline__ int perm32(int rho) { const int n = rho >> 4, i = rho & 15; return 8 * (i >> 2) + 4 * n + (i & 3); }
struct Unit { int pm, pn, k0, nt, atomic; };
struct Gemm { const bf16_t* A; const bf16_t* Bt; int M, N, K; };
template <int M, int N, int K, int WGM_ = WGM>
struct StaticOrder {
    static constexpr int nM = M / BM, nN = N / BM, nwg = nM * nN, ntk = K / BK;
    int G, c;
    __device__ __forceinline__ void init(int G_, int c_) { G = G_; c = c_; }
    __device__ __forceinline__ void map(int L, int& pm, int& pn) const {
        int wgid = L; { constexpr int q = nwg / NXCD, r = nwg % NXCD; const int xcd = wgid % NXCD, off = wgid / NXCD; wgid = (xcd < r ? xcd * (q + 1) : r * (q + 1) + (xcd - r) * q) + off; }
        constexpr int nig = WGM_ * nN; const int gid = wgid / nig, fm = gid * WGM_, gsz = (nM - fm) < WGM_ ? (nM - fm) : WGM_;
        pm = fm + ((wgid % nig) % gsz); pn = (wgid % nig) / gsz;
    }
    __device__ __forceinline__ bool next(int i, Unit& u) const {
        const int L = i * G + c; if (L >= nwg) return false;
        int pm, pn; map(L, pm, pn);
        u.pm = pm; u.pn = pn; u.k0 = 0; u.nt = ntk; u.atomic = 0; return true;
    }
};
template <int MLAT, int MTOT, int N, int K, int KS>
struct SplitTailOrder {
    StaticOrder<MLAT, N, K, 4> lat;
    static constexpr int nlat = (MLAT / BM) * (N / BM), nN = N / BM, pm0 = MLAT / BM, ntail = ((MTOT - MLAT) / BM) * nN * KS, ntk_sub = K / BK / KS;
    static_assert(KS == 1 || (K / BK) % (2 * KS) == 0, "split-K pieces need an even number of K tiles");
    __device__ __forceinline__ void init(int G_, int c_) { lat.init(G_, c_); }
    __device__ __forceinline__ bool next(int i, Unit& u) const {
        const int L = i * lat.G + lat.c;
        if (L >= nlat + ntail) return false;
        const bool tail = L >= nlat;
        int pml, pnl; lat.map(tail ? 0 : L, pml, pnl);
        const int s = tail ? L - nlat : 0, un = s / KS, ks = s % KS;
        u.pm = tail ? pm0 + un / nN : pml; u.pn = tail ? un % nN : pnl; u.nt = tail ? ntk_sub : K / BK; u.k0 = tail ? ks * ntk_sub * BK : 0; u.atomic = tail ? ks + 1 : 0;
        return true;
    }
};

struct EpiBf16 {
    static constexpr bool PERM = true;
    bf16_t* O; int ldc;
    __device__ __forceinline__ void operator()(const f32x4 (&acc)[2][2][4][2], const Unit& u, int wr, int wc, int fr, int fq) const {
        const int row0 = u.pm * BM + wr * 64 + fr, col0 = u.pn * BM + wc * 32 + 8 * fq;
#pragma unroll
        for (int ai = 0; ai < 2; ++ai)
#pragma unroll
            for (int m = 0; m < 4; ++m) { bf16_t* rowp = O + (size_t)(row0 + ai * HALF + m * 16) * ldc + col0;
#pragma unroll
                for (int bj = 0; bj < 2; ++bj) { const f32x4 v0 = acc[ai][bj][m][0], v1 = acc[ai][bj][m][1];
                    u32x4 w; w.x = cvt_pk_bf16(v0[0], v0[1]); w.y = cvt_pk_bf16(v0[2], v0[3]); w.z = cvt_pk_bf16(v1[0], v1[1]); w.w = cvt_pk_bf16(v1[2], v1[3]);
                    *(u32x4*)(rowp + bj * HALF) = w; } }
    }
};
__host__ __device__ __forceinline__ int qk_pos128(int d) { const int n = (d >> 5) & 1, q = (d & 31) + ((d >> 6) << 5); return 32 * (q >> 4) + 8 * ((q >> 2) & 3) + 4 * n + (q & 3); }
__host__ __device__ __forceinline__ int qk_pos64(int d)  { const int n = (d >> 4) & 1, q = (d & 15) + ((d >> 5) << 4); return 32 * (q >> 4) + 8 * ((q >> 2) & 3) + 4 * n + (q & 3); }
__host__ __device__ __forceinline__ int win_dest_row(int n) {
    const bool p128 = (n < 1024) || (n >= 2816 && n < 4352), p64 = (n >= 1280 && n < 2304);
    return p128 ? (n & ~127) + qk_pos128(n & 127) : (p64 ? (n & ~63) + qk_pos64(n & 63) : n);
}
struct EpiQKV {
    static constexpr bool PERM = true;
    bf16_t* O; int ldc; const float* gt; LAS float* red;
    __device__ __forceinline__ void operator()(const f32x4 (&acc)[2][2][4][2], const Unit& u, int wr, int wc, int fr_, int fq_) const {
        int fr = fr_, fq = fq_; asm volatile("" : "+v"(fr), "+v"(fq));
        const int pn = u.pn;
        const bool isv = (pn == 4) || (pn == 9) || (pn == 10) || (pn >= 17);
        if (!isv) {
            const bool hd64 = (pn >= 5 && pn <= 8);
            const bool rope = (pn <= 8) && (u.pm < 32);
            const int gidx = pn <= 2 ? 0 : (pn == 3 ? 1 : (pn <= 6 ? 2 : (pn <= 8 ? 3 : (pn <= 13 ? 4 : 5))));
            const float* gain = gt + gidx * 128;
#pragma unroll
            for (int ai = 0; ai < 2; ++ai)
#pragma unroll
                for (int m = 0; m < 4; ++m)
#pragma unroll
                    for (int bj = 0; bj < 2; ++bj) {
                        const f32x4 a0 = acc[ai][bj][m][0], a1 = acc[ai][bj][m][1];
                        float sq = (a0[0] * a0[0] + a0[1] * a0[1]) + (a0[2] * a0[2] + a0[3] * a0[3]) + (a1[0] * a1[0] + a1[1] * a1[1]) + (a1[2] * a1[2] + a1[3] * a1[3]);
                        sq += __uint_as_float((unsigned)__builtin_amdgcn_ds_swizzle((int)__float_as_uint(sq), 0x401F));
                        { auto rr = __builtin_amdgcn_permlane32_swap(__float_as_uint(sq), __float_as_uint(sq), false, false); sq = __uint_as_float(rr[0]) + __uint_as_float(rr[1]); }
                        if (fq == 0) red[((ai * HALF + wr * 64 + m * 16 + fr) * 2 + bj) * 4 + wc] = sq;
                    }
            asm volatile("s_waitcnt lgkmcnt(0)" ::: "memory"); __builtin_amdgcn_s_barrier(); asm volatile("" ::: "memory");
            const int g = hd64 ? 4 * (wc & 1) + fq : 4 * wc + fq;
            int dimb[4]; float frq[4]; bool usecol[4];
#pragma unroll
            for (int j = 0; j < 4; ++j) { const int q = 4 * g + j;
                if (hd64) { dimb[j] = q + (q >= 16 ? 16 : 0); usecol[j] = q >= 16; frq[j] = exp2f(-(float)(q & 15) * (13.287712379549449f / 16.f)); }
                else      { dimb[j] = q + (q >= 32 ? 32 : 0); usecol[j] = q >= 32; frq[j] = exp2f(-(float)(q & 31) * (13.287712379549449f / 32.f)); } }
            const int dn = hd64 ? 16 : 32;
            float g0[4], g1[4];
#pragma unroll
            for (int j = 0; j < 4; ++j) { g0[j] = gain[dimb[j]]; g1[j] = gain[dimb[j] + dn]; }
#pragma unroll
            for (int ai = 0; ai < 2; ++ai)
#pragma unroll
                for (int m = 0; m < 4; ++m) {
                    const int rl = ai * HALF + wr * 64 + m * 16 + fr, row = u.pm * BM + rl;
                    const int tt = row & (SEQ - 1); const float prow = (float)(tt >> 6), pcol = (float)(tt & 63);
                    float sn[4], cs[4];
                    if (rope) {
#pragma unroll
                        for (int j = 0; j < 4; ++j) sincos_small((usecol[j] ? pcol : prow) * frq[j], sn[j], cs[j]);
                    }
                    bf16_t* rowp = O + (size_t)row * ldc + u.pn * BM + wc * 32 + 8 * fq;
#pragma unroll
                    for (int bj = 0; bj < 2; ++bj) {
                        const f32x4 pp = *(const LAS f32x4*)(red + (rl * 2 + bj) * 4);
                        const float tot = hd64 ? ((wc & 2) ? pp[2] + pp[3] : pp[0] + pp[1]) : (pp[0] + pp[1]) + (pp[2] + pp[3]);
                        const float rstd = rsqrtf(tot * (hd64 ? 1.f / 64.f : 1.f / 128.f) + RMS_EPS);
                        float ya[4], yb[4];
#pragma unroll
                        for (int j = 0; j < 4; ++j) {
                            ya[j] = acc[ai][bj][m][0][j] * rstd * g0[j]; yb[j] = acc[ai][bj][m][1][j] * rstd * g1[j];
                            if (rope) { const float ta = ya[j] * cs[j] - yb[j] * sn[j], tb = ya[j] * sn[j] + yb[j] * cs[j]; ya[j] = ta; yb[j] = tb; }
                        }
                        u32x4 w; w.x = cvt_pk_bf16(ya[0], ya[1]); w.y = cvt_pk_bf16(ya[2], ya[3]); w.z = cvt_pk_bf16(yb[0], yb[1]); w.w = cvt_pk_bf16(yb[2], yb[3]);
                        *(u32x4*)(rowp + bj * HALF) = w;
                    }
                    __builtin_amdgcn_sched_barrier(0);
                }
            return;
        }
        const int row0 = u.pm * BM + wr * 64 + fr, col0 = u.pn * BM + wc * 32 + 8 * fq;
#pragma unroll
        for (int ai = 0; ai < 2; ++ai)
#pragma unroll
            for (int m = 0; m < 4; ++m) { bf16_t* rowp = O + (size_t)(row0 + ai * HALF + m * 16) * ldc + col0;
#pragma unroll
                for (int bj = 0; bj < 2; ++bj) { const f32x4 v0 = acc[ai][bj][m][0], v1 = acc[ai][bj][m][1];
                    u32x4 w; w.x = cvt_pk_bf16(v0[0], v0[1]); w.y = cvt_pk_bf16(v0[2], v0[3]); w.z = cvt_pk_bf16(v1[0], v1[1]); w.w = cvt_pk_bf16(v1[2], v1[3]);
                    *(u32x4*)(rowp + bj * HALF) = w; } }
    }
};
struct EpiSwiglu {
    static constexpr bool PERM = true;
    bf16_t* O; int ldc;
    __device__ __forceinline__ void operator()(const f32x4 (&acc)[2][2][4][2], const Unit& u, int wr, int wc, int fr, int fq) const {
        const int row0 = u.pm * BM + wr * 64 + fr, col0 = u.pn * HALF + wc * 32 + 8 * fq;
#pragma unroll
        for (int ai = 0; ai < 2; ++ai)
#pragma unroll
            for (int m = 0; m < 4; ++m) { bf16_t* rowp = O + (size_t)(row0 + ai * HALF + m * 16) * ldc + col0;
                float h[8];
#pragma unroll
                for (int n = 0; n < 2; ++n)
#pragma unroll
                    for (int j = 0; j < 4; ++j) { const float g = acc[ai][0][m][n][j], up = acc[ai][1][m][n][j]; h[n * 4 + j] = g * __builtin_amdgcn_rcpf(1.f + __expf(-g)) * up; }
                u32x4 w; w.x = cvt_pk_bf16(h[0], h[1]); w.y = cvt_pk_bf16(h[2], h[3]); w.z = cvt_pk_bf16(h[4], h[5]); w.w = cvt_pk_bf16(h[6], h[7]);
                *(u32x4*)rowp = w; }
    }
};
struct EpiResid {
    static constexpr bool PERM = false;
    const float* Xin; float* Xout; const float* gate; float coef;
    __device__ __forceinline__ void operator()(const f32x4 (&acc)[2][2][4][2], const Unit& u, int wr, int wc, int fr, int fq) const {
        const int grp = u.pm < 16 ? 0 : (u.pm < 32 ? 1 : 2);
        const float* gp = gate + (size_t)grp * MODW;
        const int col0 = u.pn * BM + wc * 32 + 4 * fq;
        f32x4 gv[2][2];
#pragma unroll
        for (int bj = 0; bj < 2; ++bj)
#pragma unroll
            for (int n = 0; n < 2; ++n) gv[bj][n] = *(const f32x4*)(gp + col0 + bj * HALF + n * 16) * coef;
#pragma unroll
        for (int ai = 0; ai < 2; ++ai)
#pragma unroll
            for (int m = 0; m < 4; ++m) { const size_t off = (size_t)(u.pm * BM + ai * HALF + wr * 64 + m * 16 + fr) * DM + col0;
#pragma unroll
                for (int bj = 0; bj < 2; ++bj)
#pragma unroll
                    for (int n = 0; n < 2; ++n) {
                        if (u.atomic) { float* part = (float*)((char*)Xout + (WS_PART - WS_X)); *(f32x4*)(part + (size_t)(u.atomic - 1) * MC * DM + (off - (size_t)ML * DM) + bj * HALF + n * 16) = gv[bj][n] * acc[ai][bj][m][n]; }
                        else { const f32x4 xi = *(const f32x4*)(Xin + off + bj * HALF + n * 16);
                            *(f32x4*)(Xout + off + bj * HALF + n * 16) = xi + gv[bj][n] * acc[ai][bj][m][n]; } } }
    }
};

template <class Epi, class Sched>
__device__ __forceinline__ void gemm_phase(LAS unsigned char* lds, const Gemm g, const Sched& S, const Epi& E) {
    const int tid = threadIdx.x, wid = __builtin_amdgcn_readfirstlane(tid >> 6), lane = tid & 63, wr = wid >> 2, wc = wid & 3, fr = lane & 15, fq = lane >> 4;
    const int K = g.K;
    unsigned voffA[2], voffB[2];
#pragma unroll
    for (int i = 0; i < 2; ++i) { int R, C; stage_rc(tid * 16 + i * 8192, R, C); const int Rb = Epi::PERM ? ((R & ~31) + perm32(R & 31)) : R;
        voffA[i] = (unsigned)(R * K + C) * 2u; voffB[i] = (unsigned)(Rb * K + C) * 2u; }
    const size_t kstep = (size_t)(BK * 2);
    const size_t hstep = (size_t)HALF * K * 2;
    const size_t tstep = 2 * hstep;
    const unsigned ldsw = (unsigned)wid * 1024u;
    const int aoff = lds_byte(wr * 64 + fr, fq * 8), boff = lds_byte(wc * 32 + fr, fq * 8);
#define PG8_SA(b, h) (((b) * 2 + (h)) * HTB)
#define PG8_SB(b, h) ((4 + (b) * 2 + (h)) * HTB)
#define PG8_STAGE(bufoff, gbase, voff) do { _Pragma("unroll") for (int _i = 0; _i < 2; ++_i) \
        __builtin_amdgcn_global_load_lds((const unsigned*)((const char*)(gbase) + (voff)[_i]), (LAS unsigned*)(lds + (bufoff) + ldsw + _i * 8192), 16, 0, 0); } while (0)
#define PG8_LDA(dst, b, h) do { _Pragma("unroll") for (int m = 0; m < 4; ++m) _Pragma("unroll") for (int k = 0; k < 2; ++k) dst[m][k] = *(const LAS bf16x8*)(lds + PG8_SA(b, h) + aoff + m * 2048 + k * 1024); } while (0)
#define PG8_LDB(dst, b, h) do { _Pragma("unroll") for (int n = 0; n < 2; ++n) _Pragma("unroll") for (int k = 0; k < 2; ++k) dst[n][k] = *(const LAS bf16x8*)(lds + PG8_SB(b, h) + boff + n * 2048 + k * 1024); } while (0)
#define PG8_MMA(ai, bj, At, Bt) do { __builtin_amdgcn_s_setprio(1); _Pragma("unroll") for (int m = 0; m < 4; ++m) _Pragma("unroll") for (int n = 0; n < 2; ++n) _Pragma("unroll") for (int k = 0; k < 2; ++k) \
        acc[ai][bj][m][n] = __builtin_amdgcn_mfma_f32_16x16x32_bf16(Bt[n][k], At[m][k], acc[ai][bj][m][n], 0, 0, 0); __builtin_amdgcn_s_setprio(0); } while (0)
#define PG8_WAIT_V(n) asm volatile("s_waitcnt vmcnt(" #n ")" ::: "memory")
#define PG8_WAIT_L(n) asm volatile("s_waitcnt lgkmcnt(" #n ")" ::: "memory")
#define PG8_BAR __builtin_amdgcn_s_barrier()
#define PG8_SCHED __builtin_amdgcn_sched_barrier(0)
    Unit cur, nxt; int ui = 0;
    if (!S.next(0, cur)) return;
    f32x4 acc[2][2][4][2];
#pragma unroll
    for (int a = 0; a < 2; ++a)
#pragma unroll
        for (int b = 0; b < 2; ++b)
#pragma unroll
            for (int m = 0; m < 4; ++m)
#pragma unroll
                for (int n = 0; n < 2; ++n) acc[a][b][m][n] = (f32x4){0.f, 0.f, 0.f, 0.f};
    bf16x8 At[4][2], B0[2][2], B1[2][2];
    const char* cA = (const char*)g.A + (size_t)cur.pm * tstep + (size_t)cur.k0 * 2; const char* cB = (const char*)g.Bt + (size_t)cur.pn * tstep + (size_t)cur.k0 * 2;
    PG8_STAGE(PG8_SB(0, 0), cB, voffB); PG8_STAGE(PG8_SB(0, 1), cB + hstep, voffB); PG8_STAGE(PG8_SA(0, 0), cA, voffA); PG8_STAGE(PG8_SA(0, 1), cA + hstep, voffA);
    if (wr == 1) PG8_BAR;
    PG8_WAIT_V(2); PG8_BAR;
    PG8_STAGE(PG8_SB(1, 0), cB + kstep, voffB); PG8_STAGE(PG8_SA(1, 0), cA + kstep, voffA); PG8_STAGE(PG8_SB(1, 1), cB + hstep + kstep, voffB);
    PG8_WAIT_V(6); PG8_BAR;
    for (;;) {
        const bool has_next = S.next(ui + 1, nxt);
        const char* nA = has_next ? (const char*)g.A + (size_t)nxt.pm * tstep + (size_t)nxt.k0 * 2 : cA; const char* nB = has_next ? (const char*)g.Bt + (size_t)nxt.pn * tstep + (size_t)nxt.k0 * 2 : cB;
        const int nt = cur.nt;
        for (int t = 0; t < nt; t += 2) {
            const bool last = (t == nt - 2);
            const char* a1 = cA + (size_t)(t + 1) * kstep;
            const char* a2 = last ? nA : cA + (size_t)(t + 2) * kstep; const char* b2 = last ? nB : cB + (size_t)(t + 2) * kstep;
            const char* a3 = a2 + kstep; const char* b3 = b2 + kstep;
            PG8_LDB(B0, 0, 0); PG8_LDB(B1, 0, 1); PG8_SCHED; PG8_LDA(At, 0, 0); PG8_STAGE(PG8_SA(1, 1), a1 + hstep, voffA);
            PG8_WAIT_V(8); PG8_WAIT_L(0); PG8_BAR; PG8_MMA(0, 0, At, B0); PG8_MMA(0, 1, At, B1); PG8_BAR; PG8_SCHED;
            PG8_LDA(At, 0, 1); PG8_STAGE(PG8_SB(0, 0), b2, voffB); PG8_STAGE(PG8_SB(0, 1), b2 + hstep, voffB); PG8_STAGE(PG8_SA(0, 0), a2, voffA);
            PG8_WAIT_V(8); PG8_WAIT_L(0); PG8_BAR; PG8_MMA(1, 0, At, B0); PG8_MMA(1, 1, At, B1); PG8_BAR; PG8_SCHED;
            PG8_LDB(B0, 1, 0); PG8_LDB(B1, 1, 1); PG8_SCHED; PG8_LDA(At, 1, 0); PG8_STAGE(PG8_SA(0, 1), a2 + hstep, voffA);
            PG8_WAIT_V(8); PG8_WAIT_L(0); PG8_BAR; PG8_MMA(0, 0, At, B0); PG8_MMA(0, 1, At, B1); PG8_BAR; PG8_SCHED;
            PG8_LDA(At, 1, 1); PG8_STAGE(PG8_SB(1, 0), b3, voffB); PG8_STAGE(PG8_SB(1, 1), b3 + hstep, voffB); PG8_STAGE(PG8_SA(1, 0), a3, voffA);
            PG8_WAIT_V(8); PG8_WAIT_L(0); PG8_BAR; PG8_MMA(1, 0, At, B0); PG8_MMA(1, 1, At, B1); PG8_BAR; PG8_SCHED;
        }
        if (wr == 0) PG8_BAR;
        E(acc, cur, wr, wc, fr, fq);
        if (!has_next) break;
#pragma unroll
        for (int a = 0; a < 2; ++a)
#pragma unroll
            for (int b = 0; b < 2; ++b)
#pragma unroll
                for (int m = 0; m < 4; ++m)
#pragma unroll
                    for (int n = 0; n < 2; ++n) acc[a][b][m][n] = (f32x4){0.f, 0.f, 0.f, 0.f};
        cur = nxt; cA = nA; cB = nB; ++ui;
        if (wr == 1) PG8_BAR;
    }
    PG8_WAIT_V(0);
    PG8_BAR;
#undef PG8_SA
#undef PG8_SB
#undef PG8_STAGE
#undef PG8_LDA
#undef PG8_LDB
#undef PG8_MMA
#undef PG8_WAIT_V
#undef PG8_WAIT_L
#undef PG8_BAR
#undef PG8_SCHED
}
}

struct Args { const float* in[23]; float* out; unsigned char* ws; int ph_lo, ph_hi, coop, pad; };
enum { I_X = 0, I_C, I_CTX, I_CCTX, I_WMOD, I_BMOD, I_F1GU, I_F1D, I_F2GU, I_F2D, I_WIN, I_WOUT, I_AQG, I_AKG, I_AOG, I_BQG, I_BKG, I_BLAM, I_BOG, I_CQG, I_CKG, I_CRB, I_COG };

typedef const __attribute__((address_space(4))) Args* KArgs;
__device__ __forceinline__ KArgs get_args() { KArgs p = (KArgs)__builtin_amdgcn_kernarg_segment_ptr(); asm volatile("" : "+s"(p)); return p; }

struct Ctx {
    LAS unsigned char* lds; int tid, lane, wave, G, gw, NGW;
    unsigned char* ws;
};
extern __shared__ __attribute__((aligned(16))) unsigned char lds_raw[];
__device__ __forceinline__ Ctx make_ctx(KArgs ap) {
    Ctx F; int tid = threadIdx.x, bid = blockIdx.x, G = gridDim.x;
    asm volatile("" : "+v"(tid)); asm volatile("" : "+s"(bid)); asm volatile("" : "+s"(G));
    F.lds = (LAS unsigned char*)lds_raw; F.tid = tid; F.lane = tid & 63; F.wave = __builtin_amdgcn_readfirstlane(tid >> 6);
    F.G = G; F.gw = bid * NWAVES + F.wave; F.NGW = G * NWAVES; F.ws = ap->ws;
    return F;
}

__device__ __forceinline__ void transpose_item(const float* W, int K, int N, bf16_t* WT, int k0, int n0, int drow0, LAS float* scr, int lane) {
#pragma unroll 8
    for (int i = 0; i < 32; ++i) { const int kk = 2 * i + (lane >> 5); scr[kk * 33 + (lane & 31)] = W[(size_t)(k0 + kk) * N + n0 + (lane & 31)]; }
    asm volatile("s_waitcnt lgkmcnt(0)" ::: "memory");
    const int c = lane & 7;
#pragma unroll
    for (int j = 0; j < 4; ++j) { const int n = (lane >> 3) + 8 * j; const LAS float* s = scr + (8 * c) * 33 + n;
        u32x4 o; o.x = cvt_pk_bf16(s[0 * 33], s[1 * 33]); o.y = cvt_pk_bf16(s[2 * 33], s[3 * 33]); o.z = cvt_pk_bf16(s[4 * 33], s[5 * 33]); o.w = cvt_pk_bf16(s[6 * 33], s[7 * 33]);
        *(u32x4*)(WT + (size_t)(drow0 + n) * K + k0 + 8 * c) = o; }
    asm volatile("s_waitcnt lgkmcnt(0)" ::: "memory");
}

__device__ __forceinline__ void transpose_item64(const float* W, int K, int N, bf16_t* WT, int k0, int n0, int drow0, LAS float* scr, int lane, bool win = false) {
    const int lr = lane >> 4, lc = (lane & 15) * 4;
    f32x4 v[16];
#pragma unroll
    for (int i = 0; i < 16; ++i) v[i] = *(const f32x4*)(W + (size_t)(k0 + 4 * i + lr) * N + n0 + lc);
#pragma unroll
    for (int i = 0; i < 16; ++i) { LAS float* d = scr + (4 * i + lr) * 65 + lc; d[0] = v[i].x; d[1] = v[i].y; d[2] = v[i].z; d[3] = v[i].w; }
    asm volatile("s_waitcnt lgkmcnt(0)" ::: "memory");
    const int c = lane & 7;
#pragma unroll
    for (int j = 0; j < 8; ++j) { const int n = (lane >> 3) + 8 * j; const LAS float* sp = scr + (8 * c) * 65 + n;
        u32x4 o; o.x = cvt_pk_bf16(sp[0 * 65], sp[1 * 65]); o.y = cvt_pk_bf16(sp[2 * 65], sp[3 * 65]); o.z = cvt_pk_bf16(sp[4 * 65], sp[5 * 65]); o.w = cvt_pk_bf16(sp[6 * 65], sp[7 * 65]);
        const int drow = win ? pg8::win_dest_row(n0 + n) : drow0 + n;
        *(u32x4*)(WT + (size_t)drow * K + k0 + 8 * c) = o; }
    asm volatile("s_waitcnt lgkmcnt(0)" ::: "memory");
}

__device__ __forceinline__ void phase_prologue() {
    const KArgs ap = get_args(); Ctx F = make_ctx(ap);
#define a (*ap)
    LAS float* sil = (LAS float*)(F.lds + 73728);
    for (int i = F.tid; i < 3 * DM; i += NTHR) {
        const int g = i / DM, k = i % DM;
        const float v = (g == 0) ? a.in[I_C][k] : (g == 1) ? a.in[I_C][DM + k] : a.in[I_CCTX][k];
        sil[i] = silu_f(v);
    }
    __syncthreads();
    if (F.gw / NWAVES == 1) {
        float* GT = (float*)(F.ws + WS_SCAL + 4096);
        for (int i = F.tid; i < DEPTH * 6 * 128; i += NTHR) { const int l = i / 768, r = i % 768, t = r / 128, d = r % 128;
            const int src = (t == 0) ? I_AQG : (t == 1) ? I_AKG : (t == 2) ? I_BQG : (t == 3) ? I_BKG : (t == 4) ? I_CQG : I_CKG;
            const bool b64 = (t == 2 || t == 3);
            GT[i] = b64 ? (d < 64 ? a.in[src][l * 64 + d] : 0.f) : a.in[src][l * 128 + d]; }
    }
    if (F.gw == 0) {
        for (int l = 0; l < DEPTH; ++l) {
            const float* lv = a.in[I_BLAM] + l * 256;
            const float s1 = wave_sum(lv[F.lane] * lv[64 + F.lane]), s2 = wave_sum(lv[128 + F.lane] * lv[192 + F.lane]);
            const float lam_init = (l == 0) ? 0.2f : 0.35550906f;
            if (F.lane == 0) ((float*)(F.ws + WS_SCAL))[l] = expf(s1) - expf(s2) + lam_init;
        }
    }
    {
        float* MOD = (float*)(F.ws + WS_MOD);
        LAS f32x4* red = (LAS f32x4*)(F.lds + 98304);
        constexpr int NCC = MODW / 256;
        for (int it = F.gw / NWAVES; it < DEPTH * NCC; it += F.G) {
            const int l = it / NCC, cc = it % NCC, col = cc * 256 + F.lane * 4;
            const float* W = a.in[I_WMOD] + (size_t)l * DM * MODW + col;
            f32x4 a0 = {0, 0, 0, 0}, a1 = a0, a2 = a0;
#pragma unroll 16
            for (int k = F.wave * 256; k < (F.wave + 1) * 256; ++k) {
                const f32x4 w = *(const f32x4*)(W + (size_t)k * MODW);
                const float s0 = sil[k], s1 = sil[DM + k], s2 = sil[2 * DM + k];
                a0 += w * s0; a1 += w * s1; a2 += w * s2;
            }
            red[(F.wave * 3 + 0) * 64 + F.lane] = a0; red[(F.wave * 3 + 1) * 64 + F.lane] = a1; red[(F.wave * 3 + 2) * 64 + F.lane] = a2;
            __syncthreads();
            if (F.wave < 3) {
                f32x4 t = *(const f32x4*)(a.in[I_BMOD] + (size_t)l * MODW + col);
#pragma unroll
                for (int w = 0; w < 8; ++w) t += red[(w * 3 + F.wave) * 64 + F.lane];
                *(f32x4*)(MOD + ((size_t)l * 3 + F.wave) * MODW + col) = t;
            }
            __syncthreads();
        }
    }
    __syncthreads();
    {
        constexpr int IT_GU = (DM / 64) * (2 * FF / 64), IT_D = (FF / 64) * (DM / 64), IT_IN = (DM / 64) * (INW / 64), IT_OUT = (DM / 64) * (DM / 64);
        constexpr int IT_L = 2 * IT_GU + 2 * IT_D + IT_IN + IT_OUT, IT_ALL = DEPTH * IT_L;
        LAS float* scr = (LAS float*)(F.lds + F.wave * 16640);
        int it_lo, it_hi, it_step;
        if (F.G == 256) {
            static_assert(IT_ALL == 1152 * 16 + 22528, "transpose item split");
            const int bid = F.gw / NWAVES;
            if (bid < 144) { it_lo = F.gw * 16; it_hi = it_lo + 16; }
            else { const int v = F.gw - 1152; it_lo = 18432 + (v * 176) / 7; it_hi = 18432 + ((v + 1) * 176) / 7; }
            it_step = 1;
        } else { it_lo = F.gw; it_hi = IT_ALL; it_step = F.NGW; }
        for (int rep_ = 0; rep_ < (DUP == 4 ? 2 : 1); ++rep_)
        for (int it = it_lo; it < it_hi; it += it_step) {
            const int l = it / IT_L; int r = it % IT_L;
            unsigned char* wl = F.ws + WS_W + (size_t)l * WL_STRIDE;
            const float* W; int K, N; bf16_t* WT; bool gu = false, win = false;
            if (r < IT_GU) { W = a.in[I_F1GU] + (size_t)l * DM * 2 * FF; K = DM; N = 2 * FF; WT = (bf16_t*)(wl + WO_GU1); gu = true; }
            else if ((r -= IT_GU) < IT_GU) { W = a.in[I_F2GU] + (size_t)l * DM * 2 * FF; K = DM; N = 2 * FF; WT = (bf16_t*)(wl + WO_GU2); gu = true; }
            else if ((r -= IT_GU) < IT_D) { W = a.in[I_F1D] + (size_t)l * FF * DM; K = FF; N = DM; WT = (bf16_t*)(wl + WO_D1); }
            else if ((r -= IT_D) < IT_D) { W = a.in[I_F2D] + (size_t)l * FF * DM; K = FF; N = DM; WT = (bf16_t*)(wl + WO_D2); }
            else if ((r -= IT_D) < IT_IN) { W = a.in[I_WIN] + (size_t)l * DM * INW; K = DM; N = INW; WT = (bf16_t*)(wl + WO_IN); win = true; }
            else { r -= IT_IN; W = a.in[I_WOUT] + (size_t)l * DM * DM; K = DM; N = DM; WT = (bf16_t*)(wl + WO_OUT); }
            const int nblk = N / 64, kb = r / nblk, nb = r % nblk, n0 = 64 * nb;
            int drow0 = n0;
            if (gu) { const int j = (n0 < FF) ? n0 : n0 - FF; drow0 = (j >> 7) * 256 + ((n0 < FF) ? 0 : 128) + (j & 127); }
            transpose_item64(W, K, N, WT, 64 * kb, n0, drow0, scr, F.lane, win);
        }
    }
}

#undef a
__device__ __forceinline__ void phase_norm(int l, int ishift, int nrows, int npart, int srcmode) {
    const KArgs ap = get_args(); Ctx F = make_ctx(ap);
    const float* lat_src = srcmode == 2 ? ap->in[I_X] : (const float*)(F.ws + WS_X);
    const float* ctx_src = srcmode >= 1 ? ap->in[I_CTX] : (const float*)(F.ws + WS_X) + (size_t)ML * DM;
    const float* MOD = (const float*)(F.ws + WS_MOD) + (size_t)l * 3 * MODW;
    const float* X = (const float*)(F.ws + WS_X); bf16_t* XN = (bf16_t*)(F.ws + WS_XN);
    LAS f32x4* msc = (LAS f32x4*)F.lds;
    for (int i = F.tid; i < 3 * 2 * (DM / 4); i += NTHR) { const int g = i / (2 * (DM / 4)), r = i % (2 * (DM / 4)), w = r / (DM / 4), c = r % (DM / 4);
        const f32x4 t = *((const f32x4*)(MOD + (size_t)g * MODW + (ishift + (w ? 0 : 1)) * DM) + c); msc[i] = w ? t : t + 1.f; }
    __syncthreads();
    for (int row0 = (F.gw / NWAVES) + F.G * F.wave; row0 < nrows; row0 += 2 * F.NGW) {
        const int row1 = row0 + F.NGW; const bool has1 = row1 < nrows;
        const int row1c = has1 ? row1 : row0;
        const f32x4* xr0 = (const f32x4*)(row0 < ML ? lat_src + (size_t)row0 * DM : ctx_src + (size_t)(row0 - ML) * DM) + F.lane;
        const f32x4* xr1 = (const f32x4*)(row1c < ML ? lat_src + (size_t)row1c * DM : ctx_src + (size_t)(row1c - ML) * DM) + F.lane;
        f32x4 v0[8], v1[8];
#pragma unroll
        for (int j = 0; j < 8; ++j) v0[j] = xr0[64 * j];
#pragma unroll
        for (int j = 0; j < 8; ++j) v1[j] = xr1[64 * j];
#pragma unroll
        for (int rsel = 0; rsel < 2; ++rsel) {
            const int row = rsel ? row1 : row0; if (rsel && !has1) break;
            f32x4 (&v)[8] = rsel ? v1 : v0;
            const int grp = row < SEQ ? 0 : (row < ML ? 1 : 2);
            float s = 0.f;
            if (row >= ML && npart > 0) {
                const f32x4* pr = (const f32x4*)(F.ws + WS_PART) + (size_t)(row - ML) * (DM / 4) + F.lane;
#pragma unroll 1
                for (int p = 0; p < npart; ++p) {
#pragma unroll
                    for (int j = 0; j < 8; ++j) v[j] += pr[(size_t)p * MC * (DM / 4) + 64 * j]; }
                f32x4* xw = (f32x4*)(F.ws + WS_X + (size_t)row * DM * 4) + F.lane;
#pragma unroll
                for (int j = 0; j < 8; ++j) xw[64 * j] = v[j];
            }
#pragma unroll
            for (int j = 0; j < 8; ++j) s += (v[j].x * v[j].x + v[j].y * v[j].y) + (v[j].z * v[j].z + v[j].w * v[j].w);
            const float rstd = rsqrtf(wave_sum(s) * (1.f / DM) + RMS_EPS);
            const LAS f32x4* sc = msc + (grp * 2 + 0) * (DM / 4) + F.lane; const LAS f32x4* sh = msc + (grp * 2 + 1) * (DM / 4) + F.lane;
            u32x2* o = (u32x2*)(XN + (size_t)row * DM) + F.lane;
#pragma unroll
            for (int j = 0; j < 8; ++j) { const f32x4 y = v[j] * rstd * sc[64 * j] + sh[64 * j]; u32x2 w; w.x = cvt_pk_bf16(y.x, y.y); w.y = cvt_pk_bf16(y.z, y.w); o[64 * j] = w; }
        }
    }
}

template <int HDIM> struct QkMap {
    static constexpr int LPH = HDIM / 4, LPHALF = HDIM / 8;
    int hs, half, ip, a0, b0;
    __device__ __forceinline__ QkMap(int lane) { hs = lane / LPH; const int u = lane % LPH; half = u / LPHALF; ip = u % LPHALF; a0 = half * (HDIM / 2) + 2 * ip; b0 = a0 + HDIM / 4; }
};
template <int HDIM>
__device__ __forceinline__ void qk_compute(unsigned& ua, unsigned& ub, const QkMap<HDIM>& m, const float* gain, bool rope, int prow_pos, int pcol_pos) {
    float xa0 = bf_lo(ua), xa1 = bf_hi(ua), xb0 = bf_lo(ub), xb1 = bf_hi(ub);
    float ss = xa0 * xa0 + xa1 * xa1 + xb0 * xb0 + xb1 * xb1;
    ss = group_sum<QkMap<HDIM>::LPH>(ss);
    const float rstd = rsqrtf(ss * (1.f / HDIM) + RMS_EPS);
    xa0 *= rstd * gain[m.a0]; xa1 *= rstd * gain[m.a0 + 1]; xb0 *= rstd * gain[m.b0]; xb1 *= rstd * gain[m.b0 + 1];
    if (rope) {
        const float pos = (float)(m.half ? pcol_pos : prow_pos);
        constexpr float L2T = 13.287712379549449f;
        const float f0 = exp2f(-(float)(2 * m.ip) * (L2T / (HDIM / 4))), f1 = exp2f(-(float)(2 * m.ip + 1) * (L2T / (HDIM / 4)));
        float s0, c0, s1, c1; sincos_small(pos * f0, s0, c0); sincos_small(pos * f1, s1, c1);
        const float ya0 = xa0 * c0 - xb0 * s0, yb0 = xa0 * s0 + xb0 * c0, ya1 = xa1 * c1 - xb1 * s1, yb1 = xa1 * s1 + xb1 * c1;
        xa0 = ya0; xb0 = yb0; xa1 = ya1; xb1 = yb1;
    }
    ua = cvt_pk_bf16(xa0, xa1); ub = cvt_pk_bf16(xb0, xb1);
}
__device__ __forceinline__ void phase_qk(int l) {
    const KArgs ap = get_args(); Ctx F = make_ctx(ap);
#define a (*ap)
    bf16_t* P = (bf16_t*)(F.ws + WS_P);
    const float* aqg = a.in[I_AQG] + l * 128; const float* akg = a.in[I_AKG] + l * 128;
    const float* bqg = a.in[I_BQG] + l * 64;  const float* bkg = a.in[I_BKG] + l * 64;
    const float* cqg = a.in[I_CQG] + l * 128; const float* ckg = a.in[I_CKG] + l * 128;
    const QkMap<128> m1(F.lane); const QkMap<64> m2(F.lane);
    constexpr int NS = 14;
    constexpr int scol[NS] = {OFF_AQ, OFF_AQ + 256, OFF_AQ + 512, OFF_AK, OFF_BQ, OFF_BQ + 256, OFF_BK, OFF_BK + 256, OFF_CQ, OFF_CQ + 256, OFF_CQ + 512, OFF_CK, OFF_CK + 256, OFF_CK + 512};
    for (int row = (F.gw / NWAVES) + F.G * F.wave; row < MT; row += F.NGW) {
        bf16_t* pr = P + (size_t)row * INW;
        const bool lat = row < ML; const int t = row & (SEQ - 1), rr = t >> 6, cc = t & 63;
        unsigned ua[NS], ub[NS];
#pragma unroll
        for (int s = 0; s < NS; ++s) { const bool isb = (s >= 4 && s < 8);
            const int oa = scol[s] + (isb ? m2.hs * 64 + m2.a0 : m1.hs * 128 + m1.a0), ob = scol[s] + (isb ? m2.hs * 64 + m2.b0 : m1.hs * 128 + m1.b0);
            ua[s] = *(const unsigned*)(pr + oa); ub[s] = *(const unsigned*)(pr + ob); }
#pragma unroll
        for (int s = 0; s < NS; ++s) {
            if (s < 3) qk_compute<128>(ua[s], ub[s], m1, aqg, lat, rr, cc);
            else if (s == 3) qk_compute<128>(ua[s], ub[s], m1, akg, lat, rr, cc);
            else if (s < 6) qk_compute<64>(ua[s], ub[s], m2, bqg, lat, rr, cc);
            else if (s < 8) qk_compute<64>(ua[s], ub[s], m2, bkg, lat, rr, cc);
            else if (s < 11) qk_compute<128>(ua[s], ub[s], m1, cqg, false, rr, cc);
            else qk_compute<128>(ua[s], ub[s], m1, ckg, false, rr, cc);
        }
#pragma unroll
        for (int s = 0; s < NS; ++s) { const bool isb = (s >= 4 && s < 8);
            const int oa = scol[s] + (isb ? m2.hs * 64 + m2.a0 : m1.hs * 128 + m1.a0), ob = scol[s] + (isb ? m2.hs * 64 + m2.b0 : m1.hs * 128 + m1.b0);
            *(unsigned*)(pr + oa) = ua[s]; *(unsigned*)(pr + ob) = ub[s]; }
    }
}

#undef a
struct NaiveAcc { float m, l, o0, o1; };
__device__ __forceinline__ void naive_key(NaiveAcc& A, const bf16_t* P, int krow, int kcol, int vcol, float q0, float q1, float scale, float bias, int lane) {
    const unsigned kk = *(const unsigned*)(P + (size_t)krow * INW + kcol + 2 * lane);
    const float s = wave_sum(q0 * bf_lo(kk) + q1 * bf_hi(kk)) * scale + bias;
    const float mn = fmaxf(A.m, s), al = __expf(A.m - mn), p = __expf(s - mn);
    const unsigned vv = *(const unsigned*)(P + (size_t)krow * INW + vcol + 2 * lane);
    A.l = A.l * al + p; A.o0 = A.o0 * al + p * bf_lo(vv); A.o1 = A.o1 * al + p * bf_hi(vv); A.m = mn;
}
__device__ __forceinline__ void phase_attn_naive(int l, bool with_ctx) {
    const KArgs ap = get_args(); Ctx F = make_ctx(ap);
#define a (*ap)
    const bf16_t* P = (const bf16_t*)(F.ws + WS_P); bf16_t* AO = (bf16_t*)(F.ws + WS_AO);
    const float lam = ((const float*)(F.ws + WS_SCAL))[l];
    const int nrows = with_ctx ? MT : ML;
    const int nitems = nrows * 16;
    for (int it = F.gw; it < nitems; it += F.NGW) {
        int row, hd;
        if (it < ML * 16) { const int b = it / (SEQ * 16), r = it % (SEQ * 16); hd = r / SEQ; row = b * SEQ + r % SEQ; }
        else { const int r0 = it - ML * 16; const int b = r0 / (CTX * 16), r = r0 % (CTX * 16); hd = r / CTX; row = ML + b * CTX + r % CTX; }
        const bool lat = row < ML; const int b = lat ? row / SEQ : (row - ML) / CTX;
        const int t = row & (SEQ - 1), qr = t >> 6, qc = t & 63;
        const int ctx0 = ML + b * CTX, lat0 = b * SEQ;
        float o0, o1;
        if (hd < 6 || hd >= 10) {
            const bool isC = hd >= 10; const int h = isC ? hd - 10 : hd;
            const int qcol = isC ? OFF_CQ + h * 128 : OFF_AQ + h * 128;
            const int kcol = isC ? OFF_CK + h * 128 : OFF_AK + (h / 3) * 128;
            const int vcol = isC ? OFF_CV + h * 128 : OFF_AV + (h / 3) * 128;
            const unsigned qq = *(const unsigned*)(P + (size_t)row * INW + qcol + 2 * F.lane);
            const float q0 = bf_lo(qq), q1 = bf_hi(qq); const float scale = 0.08838834764831845f;
            NaiveAcc A{-1e30f, 0.f, 0.f, 0.f};
            for (int i = 0; i < CTX; ++i) naive_key(A, P, ctx0 + i, kcol, vcol, q0, q1, scale, 0.f, F.lane);
            if (lat) {
                if (!isC) { for (int i = 0; i < SEQ; ++i) naive_key(A, P, lat0 + i, kcol, vcol, q0, q1, scale, 0.f, F.lane); }
                else {
                    const int rs = min(max(qr - 4, 0), 56), cs = min(max(qc - 8, 0), 48);
                    const float* rb = a.in[I_CRB] + ((size_t)l * 6 + h) * 15 * 31;
                    for (int w = 0; w < 128; ++w) { const int kr = rs + (w >> 4), kc = cs + (w & 15);
                        naive_key(A, P, lat0 + kr * 64 + kc, kcol, vcol, q0, q1, scale, rb[(kr - qr + 7) * 31 + (kc - qc + 15)], F.lane); }
                }
            }
            const float il = 1.f / A.l; o0 = A.o0 * il; o1 = A.o1 * il;
        } else {
            const int h = hd - 6; const int vcol = OFF_BV + h * 128; const float scale = 0.125f;
            float r0[2], r1[2];
#pragma unroll 1
            for (int sub = 0; sub < 2; ++sub) {
                const int qcol = OFF_BQ + h * 128 + sub * 64, kcol = OFF_BK + h * 128 + sub * 64;
                const unsigned qq = *(const unsigned*)(P + (size_t)row * INW + qcol + 2 * F.lane);
                const float q0 = F.lane < 32 ? bf_lo(qq) : 0.f, q1 = F.lane < 32 ? bf_hi(qq) : 0.f;
                NaiveAcc A{-1e30f, 0.f, 0.f, 0.f};
                for (int i = 0; i < CTX; ++i) naive_key(A, P, ctx0 + i, kcol, vcol, q0, q1, scale, 0.f, F.lane);
                if (lat) for (int i = 0; i < SEQ; ++i) naive_key(A, P, lat0 + i, kcol, vcol, q0, q1, scale, 0.f, F.lane);
                const float il = 1.f / A.l; r0[sub] = A.o0 * il; r1[sub] = A.o1 * il;
            }
            o0 = r0[0] - lam * r0[1]; o1 = r1[0] - lam * r1[1];
        }
        *(unsigned*)(AO + (size_t)row * DM + hd * 128 + 2 * F.lane) = cvt_pk_bf16(o0, o1);
    }
}

#undef a
namespace fa {
using f32x16 = __attribute__((ext_vector_type(16))) float;
using s16x4 = __attribute__((ext_vector_type(4))) short;
constexpr int D = 128, NW = 8, QBLK = 32, KVBLK = 64, LDK = INW;
constexpr int SHM_V = KVBLK * D * 2, SHM_K = KVBLK * D * 2;
constexpr int NSLOT = 3;
constexpr int OFF_WS = NSLOT * SHM_V + NSLOT * SHM_K, OFF_BIAS = OFF_WS + NW * 64 * 4, OFF_UNIT = OFF_BIAS + 2048;
constexpr float THR = 8.f, NEG = -1e30f;
#define KSWZ(row, colB) ((row) * 256 + ((colB) ^ (((row) & 7) << 4)))
#define SBAR() __builtin_amdgcn_sched_barrier(0)
__device__ __forceinline__ int crow(int r, int hi) { return (r & 3) + 8 * (r >> 2) + 4 * hi; }

template <int MODE> struct Sc { static constexpr float SCALE = (MODE == 1) ? 0.125f : 0.088388347648318440f; };

template <int MODE>
__device__ __forceinline__ void partialSM(f32x16& p0, f32x16& p1, float& m_reg, float& mn, float& alpha) {
  constexpr float SCALE = Sc<MODE>::SCALE, C = SCALE * 1.4426950408889634f;
  float pmax = p0[0];
#pragma unroll
  for (int r = 1; r < 16; ++r) pmax = fmaxf(pmax, p0[r]);
#pragma unroll
  for (int r = 0; r < 16; ++r) pmax = fmaxf(pmax, p1[r]);
  { auto rr = __builtin_amdgcn_permlane32_swap(__float_as_uint(pmax), __float_as_uint(pmax), false, false);
    pmax = fmaxf(__uint_as_float(rr[0]), __uint_as_float(rr[1])); }
  if (__builtin_expect(__all(pmax - m_reg <= THR / SCALE), 1)) { mn = m_reg; alpha = 1.f; }
  else { mn = fmaxf(m_reg, pmax); alpha = __builtin_amdgcn_exp2f((m_reg - mn) * C); m_reg = mn; }
  const float mnC = -mn * C;
#pragma unroll
  for (int r = 0; r < 16; ++r) p0[r] = fmaf(p0[r], C, mnC);
#pragma unroll
  for (int r = 0; r < 16; ++r) p1[r] = fmaf(p1[r], C, mnC);
#pragma unroll
  for (int r = 0; r < 16; ++r) p0[r] = __builtin_amdgcn_exp2f(p0[r]);
}
__device__ __forceinline__ void finishSM(f32x16& p0, f32x16& p1, float alpha, float& l_reg, bf16x8& pa0, bf16x8& pa1, bf16x8& pa2, bf16x8& pa3) {
#pragma unroll
  for (int r = 0; r < 16; ++r) p1[r] = __builtin_amdgcn_exp2f(p1[r]);
  float ps = 0;
#pragma unroll
  for (int r = 0; r < 16; ++r) ps += p0[r];
#pragma unroll
  for (int r = 0; r < 16; ++r) ps += p1[r];
  { auto rr = __builtin_amdgcn_permlane32_swap(__float_as_uint(ps), __float_as_uint(ps), false, false);
    ps = __uint_as_float(rr[0]) + __uint_as_float(rr[1]); }
  l_reg = l_reg * alpha + ps;
#define PK4(P, BASE, OUT) do { unsigned a0 = cvt_pk_bf16(P[BASE + 0], P[BASE + 1]), a1 = cvt_pk_bf16(P[BASE + 2], P[BASE + 3]);   \
    unsigned b0 = cvt_pk_bf16(P[BASE + 4], P[BASE + 5]), b1 = cvt_pk_bf16(P[BASE + 6], P[BASE + 7]);                              \
    auto r0 = __builtin_amdgcn_permlane32_swap(a0, b0, false, false); auto r1 = __builtin_amdgcn_permlane32_swap(a1, b1, false, false); \
    u32x4 w = {r0[0], r1[0], r0[1], r1[1]}; OUT = *reinterpret_cast<bf16x8*>(&w); } while (0)
  PK4(p0, 0, pa0); PK4(p0, 8, pa1); PK4(p1, 0, pa2); PK4(p1, 8, pa3);
#undef PK4
}
template <int ND0>
__device__ __forceinline__ void qkt(f32x16& p0, f32x16& p1, const char* Ks0, const bf16x8* qr, int r32, int hi, int kcb) {
  p0 = f32x16{}; p1 = f32x16{};
  const char* Ks = Ks0 + kcb;
#pragma unroll
  for (int d0 = 0; d0 < ND0; ++d0) { const int cb = (d0 * 16 + hi * 8) * 2;
    const bf16x8 b0 = *reinterpret_cast<const bf16x8*>(Ks + KSWZ(r32, cb));
    const bf16x8 b1 = *reinterpret_cast<const bf16x8*>(Ks + KSWZ(32 + r32, cb));
    p0 = __builtin_amdgcn_mfma_f32_32x32x16_bf16(b0, qr[d0], p0, 0, 0, 0);
    p1 = __builtin_amdgcn_mfma_f32_32x32x16_bf16(b1, qr[d0], p1, 0, 0, 0); }
}
__device__ __forceinline__ int v_st(int k, int c) { const int kk = (k & ~0xC) | ((k & 4) << 1) | ((k & 8) >> 1); return ((kk >> 3) * 4 + (c >> 5)) * 512 + ((kk & 7) * 32 + (c & 31)) * 2; }
__device__ __forceinline__ int v_rd_base(int lane) { return ((lane & 3) << 3) | (((lane >> 2) & 3) << 6) | (((lane >> 4) & 1) << 5) | (((lane >> 5) & 1) << 8); }
constexpr int v_rd_off(int d0, int ks, int half) { return d0 * 512 + ks * 4096 + half * 2048; }
template <int OFF> __device__ __forceinline__ s16x4 tr_read(int vb) {
  s16x4 r; asm volatile("ds_read_b64_tr_b16 %0, %1 offset:%2" : "=&v"(r) : "v"(vb), "i"(OFF) : "memory"); return r;
}
template <int D0> __device__ __forceinline__ void pv_one(f32x16& od, int vb, bf16x8 pa0, bf16x8 pa1, bf16x8 pa2, bf16x8 pa3) {
  const s16x4 l0 = tr_read<v_rd_off(D0, 0, 0)>(vb), h0 = tr_read<v_rd_off(D0, 0, 1)>(vb), l1 = tr_read<v_rd_off(D0, 1, 0)>(vb), h1 = tr_read<v_rd_off(D0, 1, 1)>(vb);
  const s16x4 l2 = tr_read<v_rd_off(D0, 2, 0)>(vb), h2 = tr_read<v_rd_off(D0, 2, 1)>(vb), l3 = tr_read<v_rd_off(D0, 3, 0)>(vb), h3 = tr_read<v_rd_off(D0, 3, 1)>(vb);
  asm volatile("s_waitcnt lgkmcnt(0)" ::: "memory"); SBAR();
#define PK(L, H) (bf16x8){L[0], L[1], L[2], L[3], H[0], H[1], H[2], H[3]}
  od = __builtin_amdgcn_mfma_f32_32x32x16_bf16(pa0, PK(l0, h0), od, 0, 0, 0);
  od = __builtin_amdgcn_mfma_f32_32x32x16_bf16(pa1, PK(l1, h1), od, 0, 0, 0);
  od = __builtin_amdgcn_mfma_f32_32x32x16_bf16(pa2, PK(l2, h2), od, 0, 0, 0);
  od = __builtin_amdgcn_mfma_f32_32x32x16_bf16(pa3, PK(l3, h3), od, 0, 0, 0);
#undef PK
}
__device__ __forceinline__ void pv_d0(f32x16* o, int vb, bf16x8 pa0, bf16x8 pa1, bf16x8 pa2, bf16x8 pa3) {
  pv_one<0>(o[0], vb, pa0, pa1, pa2, pa3); pv_one<1>(o[1], vb, pa0, pa1, pa2, pa3); pv_one<2>(o[2], vb, pa0, pa1, pa2, pa3); pv_one<3>(o[3], vb, pa0, pa1, pa2, pa3);
}
__device__ __forceinline__ void cmask(f32x16& p0, f32x16& p1, int kr, int qrow, int qcol, int hi, const float* bias) {
  const int rs = min(max(qrow - 4, 0), 56);
  if (kr < rs || kr >= rs + 8) {
#pragma unroll
    for (int r = 0; r < 16; ++r) { p0[r] = NEG; p1[r] = NEG; }
    return;
  }
  const int cs = min(max(qcol - 8, 0), 48);
  const float* brow = bias + (kr - qrow + 7) * 31 + (15 - qcol);
#pragma unroll
  for (int r = 0; r < 16; ++r) { const int kc = crow(r, hi);
    p0[r] = ((unsigned)(kc - cs) < 16u) ? p0[r] + brow[kc] : NEG;
    p1[r] = ((unsigned)(kc + 32 - cs) < 16u) ? p1[r] + brow[kc + 32] : NEG; }
}

struct Unit { int qrow0, qcol, kcol, vcol, ocol, seg0, seg1, NT, r0, win; float lam; };

template <int MODE>
__device__ __forceinline__ void attn_unit(const bf16_t* __restrict__ P, bf16_t* __restrict__ AO, const Unit u, char* lds) {
  constexpr int ND0 = (MODE == 1) ? 4 : 8;
  int tid = threadIdx.x; asm volatile("" : "+v"(tid));
  const int wid = __builtin_amdgcn_readfirstlane(tid >> 6), lane = tid & 63, r32 = lane & 31, hi = lane >> 5;
  const int sub = (MODE == 1) ? (wid >> 2) : 0, wq = (MODE == 1) ? (wid & 3) : wid;
  char* V_lds = lds; char* K_lds = lds + NSLOT * SHM_V;
  float* wsf = (float*)(lds + OFF_WS) + wid * 64; float* li_l = wsf; float* al_l = wsf + 32;
  const float* bias = (const float*)(lds + OFF_BIAS);
  float m_reg = NEG, l_reg = 0; f32x16 o[4] = {}; bf16x8 qr[ND0];
  const bf16_t* Qw = P + (size_t)(u.qrow0 + wq * QBLK + r32) * INW + u.qcol + sub * 64 + hi * 8;
#pragma unroll
  for (int d0 = 0; d0 < ND0; ++d0) qr[d0] = *reinterpret_cast<const bf16x8*>(Qw + d0 * 16);
  const int kcb = sub * 128;
  const int sr = tid >> 4, sc = (tid & 15) * 8, vst0 = v_st(sr, sc), vst1 = v_st(32 + sr, sc);
  const int vb0 = (int)(uintptr_t)V_lds + v_rd_base(lane);
  const unsigned kgo = (unsigned)((sr * INW + u.kcol + sc) * 2), vgo = (unsigned)((sr * INW + u.vcol + sc) * 2);
  constexpr int SD = (MODE == 2) ? 1 : 2;
  struct { bf16x8 vs0, vs1, ks0, ks1; } sr_[SD];
#define TROW(t) ((size_t)((t) < 4 ? u.seg0 + 64 * (t) : u.seg1 + 64 * ((t) - 4)) * (INW * 2))
#define SLOAD(i, t) do { const char* tb_ = (const char*)P + TROW(t); sr_[i].vs0 = *reinterpret_cast<const bf16x8*>(tb_ + vgo); sr_[i].vs1 = *reinterpret_cast<const bf16x8*>(tb_ + 32 * INW * 2 + vgo); \
    sr_[i].ks0 = *reinterpret_cast<const bf16x8*>(tb_ + kgo); sr_[i].ks1 = *reinterpret_cast<const bf16x8*>(tb_ + 32 * INW * 2 + kgo); } while (0)
#define SWRITE(so, i) do { *(bf16x8*)(V_lds + (so) + vst0) = sr_[i].vs0; *(bf16x8*)(V_lds + (so) + vst1) = sr_[i].vs1; const int kc = sc * 2; \
    *(bf16x8*)(K_lds + (so) + KSWZ(sr, kc)) = sr_[i].ks0; *(bf16x8*)(K_lds + (so) + KSWZ(32 + sr, kc)) = sr_[i].ks1; } while (0)
#define ROT() do { sP = sC; sC = sN; sN = (sN == (NSLOT - 1) * SHM_V) ? 0 : sN + SHM_V; } while (0)
#define SWAIT() do { if (SD == 2) asm volatile("s_waitcnt vmcnt(4)" ::: "memory"); else asm volatile("s_waitcnt vmcnt(0)" ::: "memory"); } while (0)
#define RESC(a) do { if (__any((a) < 1.f)) { if (hi == 0) al_l[r32] = (a); asm volatile("s_waitcnt lgkmcnt(0)" ::: "memory"); \
    _Pragma("unroll") for (int d = 0; d < 4; ++d) _Pragma("unroll") for (int r = 0; r < 16; ++r) o[d][r] *= al_l[crow(r, hi)]; } } while (0)
  const int qrow_g = u.r0 + (wid >> 1), qcol_g = 32 * (wid & 1) + r32;
#define CM(P0, P1, t) do { if (MODE == 2 && u.win && (t) >= 4) cmask(P0, P1, u.seg1 / 64 % 64 + (t) - 4, qrow_g, qcol_g, hi, bias); } while (0)
  f32x16 pA0, pA1, pB0, pB1; float mnA, mnB, alA, alB; bf16x8 pa0, pa1, pa2, pa3; const int NT = u.NT;
  constexpr int SE = 0, SO = SD - 1;
  int sP = 0, sC = 0, sN = SHM_V;
  if (SD == 2) {
    SLOAD(SE, 0); SLOAD(SO, 1); asm volatile("s_waitcnt vmcnt(4)" ::: "memory"); SWRITE(0, SE); __syncthreads();
    qkt<ND0>(pA0, pA1, K_lds, qr, r32, hi, kcb); partialSM<MODE>(pA0, pA1, m_reg, mnA, alA);
    if (2 < NT) SLOAD(SE, 2);
    SWAIT(); SWRITE(SHM_V, SO); __syncthreads();
  } else {
    SLOAD(SE, 0); asm volatile("s_waitcnt vmcnt(0)" ::: "memory"); SWRITE(0, SE); __syncthreads();
    qkt<ND0>(pA0, pA1, K_lds, qr, r32, hi, kcb); partialSM<MODE>(pA0, pA1, m_reg, mnA, alA);
    SLOAD(SO, 1);
    SWAIT(); SWRITE(SHM_V, SO); __syncthreads();
  }
  sP = 0; sC = SHM_V; sN = 2 * SHM_V;
  for (int j = 1; j + 1 < NT; j += 2) {
    SBAR(); qkt<ND0>(pB0, pB1, K_lds + sC, qr, r32, hi, kcb);
    finishSM(pA0, pA1, alA, l_reg, pa0, pa1, pa2, pa3); SBAR();
    SLOAD(SO, j + SD); SBAR();
    pv_d0(o, vb0 + sP, pa0, pa1, pa2, pa3); CM(pB0, pB1, j); partialSM<MODE>(pB0, pB1, m_reg, mnB, alB);
    SWAIT(); SWRITE(sN, SE);
    RESC(alB); __syncthreads(); ROT();
    SBAR(); qkt<ND0>(pA0, pA1, K_lds + sC, qr, r32, hi, kcb);
    finishSM(pB0, pB1, alB, l_reg, pa0, pa1, pa2, pa3); SBAR();
    if (SD == 1 || j + 3 < NT) SLOAD(SE, j + 1 + SD); SBAR();
    pv_d0(o, vb0 + sP, pa0, pa1, pa2, pa3); CM(pA0, pA1, j + 1); partialSM<MODE>(pA0, pA1, m_reg, mnA, alA);
    SWAIT(); SWRITE(sN, SO);
    RESC(alA); __syncthreads(); ROT();
  }
  SBAR(); qkt<ND0>(pB0, pB1, K_lds + sC, qr, r32, hi, kcb);
  finishSM(pA0, pA1, alA, l_reg, pa0, pa1, pa2, pa3); SBAR();
  pv_d0(o, vb0 + sP, pa0, pa1, pa2, pa3); CM(pB0, pB1, NT - 1); partialSM<MODE>(pB0, pB1, m_reg, mnB, alB);
  RESC(alB);
  finishSM(pB0, pB1, alB, l_reg, pa0, pa1, pa2, pa3); SBAR();
  pv_d0(o, vb0 + sC, pa0, pa1, pa2, pa3);
  if (hi == 0) li_l[r32] = l_reg; asm volatile("s_waitcnt lgkmcnt(0)" ::: "memory");
  float rli[16];
#pragma unroll
  for (int r = 0; r < 16; ++r) rli[r] = __builtin_amdgcn_rcpf(li_l[crow(r, hi)]);
  bf16_t* Ow = AO + (size_t)(u.qrow0 + wq * QBLK) * DM + u.ocol;
  if (MODE == 1) {
    float* X = (float*)lds;
    __syncthreads();
    if (sub == 1) {
#pragma unroll
      for (int d0 = 0; d0 < 4; ++d0)
#pragma unroll
        for (int r = 0; r < 16; ++r) X[((d0 * 16 + r) * 4 + wq) * 64 + lane] = o[d0][r] * rli[r];
    }
    __syncthreads();
    if (sub == 0) {
#pragma unroll
      for (int r = 0; r < 16; ++r) { const int orow = crow(r, hi);
#pragma unroll
        for (int d0 = 0; d0 < 4; ++d0) { const float v = o[d0][r] * rli[r] - u.lam * X[((d0 * 16 + r) * 4 + wq) * 64 + lane];
          Ow[(size_t)orow * DM + d0 * 32 + r32] = (bf16_t)(cvt_pk_bf16(v, 0.f) & 0xffffu); } }
    }
  } else {
#pragma unroll
    for (int r = 0; r < 16; ++r) { const int orow = crow(r, hi);
#pragma unroll
      for (int d0 = 0; d0 < 4; ++d0) Ow[(size_t)orow * DM + d0 * 32 + r32] = (bf16_t)(cvt_pk_bf16(o[d0][r] * rli[r], 0.f) & 0xffffu); }
  }
#undef TROW
#undef SLOAD
#undef SWRITE
#undef ROT
#undef SWAIT
#undef RESC
#undef CM
}
#undef KSWZ
#undef SBAR
}

__device__ __forceinline__ void phase_attn(int l, bool with_ctx, int ctr_off, int u_lo = 0, int u_hi = 100000) {
    const KArgs ap = get_args(); Ctx F = make_ctx(ap);
    const bf16_t* P = (const bf16_t*)(F.ws + WS_P); bf16_t* AO = (bf16_t*)(F.ws + WS_AO);
    unsigned* ctr0 = (unsigned*)(F.ws + WS_CTL) + 256 + l * 256 + ctr_off * 4;
    const float lam = ((const float*)(F.ws + WS_SCAL))[l];
    char* lds = (char*)lds_raw;
    volatile unsigned* uw = (volatile unsigned*)(lds + fa::OFF_UNIT);
    const int NUX = with_ctx ? 85 : 80;
    const int myx = (int)((unsigned)__builtin_amdgcn_s_getreg((3 << 11) | 20) & 7u);
#pragma unroll 1
    for (int qi = 0; qi < 8; ++qi) {
        const int x = (myx + qi) & 7;
        for (;;) {
            __syncthreads();
            if (F.tid == 0) *uw = atomicAdd(ctr0 + 16 * x, 1u);
            __syncthreads();
            const int i = (int)*uw;
            if (i >= NUX) break;
            fa::Unit u; u.lam = lam; u.win = 0; u.r0 = 0; u.seg1 = 0;
            if (i < 32) {
                const int b = x >> 2, h = x & 3, qb = i;
                if (u_lo <= 192 && 192 < u_hi) {
                u.qrow0 = b * SEQ + qb * 128; u.qcol = OFF_BQ + h * 128; u.kcol = OFF_BK + h * 128; u.vcol = OFF_BV + h * 128; u.ocol = 768 + h * 128;
                u.seg0 = ML + b * CTX; u.seg1 = b * SEQ; u.NT = 68;
                fa::attn_unit<1>(P, AO, u, lds); }
            } else if (i < 56) {
                const int st = x >> 1, b = st >> 1, kvh = st & 1, w = (x & 1) * 24 + (i - 32), h = kvh * 3 + w / 16, qb = w % 16;
                if (u_lo <= 0 && 0 < u_hi) {
                u.qrow0 = b * SEQ + qb * 256; u.qcol = OFF_AQ + h * 128; u.kcol = OFF_AK + kvh * 128; u.vcol = OFF_AV + kvh * 128; u.ocol = h * 128;
                u.seg0 = ML + b * CTX; u.seg1 = b * SEQ; u.NT = 68;
                fa::attn_unit<0>(P, AO, u, lds); }
            } else if (i < 80) {
                const int v = x * 24 + (i - 56), b = v / 96, h = (v % 96) / 16, qb = v % 16;
                const int r0 = qb * 4, rbase = min(max(r0 - 4, 0), 52);
                if (u_lo <= 448 && 448 < u_hi) {
                u.qrow0 = b * SEQ + qb * 256; u.qcol = OFF_CQ + h * 128; u.kcol = OFF_CK + h * 128; u.vcol = OFF_CV + h * 128; u.ocol = 1280 + h * 128;
                u.seg0 = ML + b * CTX; u.seg1 = b * SEQ + rbase * 64; u.NT = 16; u.r0 = r0; u.win = 1;
                { const float* rb = ap->in[I_CRB] + ((size_t)l * 6 + h) * 465; float* bl = (float*)(lds + fa::OFF_BIAS);
                  if (F.tid < 465) bl[F.tid] = rb[F.tid] * 11.313708498984761f; }
                fa::attn_unit<2>(P, AO, u, lds); }
            } else if (u_hi > 640) {
                const int v = x * 5 + (i - 80);
                u.NT = 4;
                if (v < 12) { const int b = v / 6, h = v % 6;
                    u.qrow0 = ML + b * CTX; u.qcol = OFF_AQ + h * 128; u.kcol = OFF_AK + (h / 3) * 128; u.vcol = OFF_AV + (h / 3) * 128; u.ocol = h * 128; u.seg0 = ML + b * CTX;
                    fa::attn_unit<0>(P, AO, u, lds);
                } else if (v < 28) { const int w = v - 12, b = w / 8, h = (w % 8) / 2, qb = w % 2;
                    u.qrow0 = ML + b * CTX + qb * 128; u.qcol = OFF_BQ + h * 128; u.kcol = OFF_BK + h * 128; u.vcol = OFF_BV + h * 128; u.ocol = 768 + h * 128; u.seg0 = ML + b * CTX;
                    fa::attn_unit<1>(P, AO, u, lds);
                } else { const int w = v - 28, b = w / 6, h = w % 6;
                    u.qrow0 = ML + b * CTX; u.qcol = OFF_CQ + h * 128; u.kcol = OFF_CK + h * 128; u.vcol = OFF_CV + h * 128; u.ocol = 1280 + h * 128; u.seg0 = ML + b * CTX;
                    fa::attn_unit<0>(P, AO, u, lds);
                }
            }
        }
    }
}

__device__ __forceinline__ void phase_n3(int l, int nrows) {
    const KArgs ap = get_args(); Ctx F = make_ctx(ap);
#define a (*ap)
    bf16_t* AO = (bf16_t*)(F.ws + WS_AO);
    const float* ag = a.in[I_AOG] + l * 768; const float* bg = a.in[I_BOG] + l * 128; const float* cgn = a.in[I_COG] + l * 768;
    const float bmul = 1.f - ((l == 0) ? 0.2f : 0.35550906f);
    for (int row = (F.gw / NWAVES) + F.G * F.wave; row < nrows; row += F.NGW) {
        u32x4* pr = (u32x4*)(AO + (size_t)row * DM) + F.lane;
        float v[4][8]; float ss[4];
#pragma unroll
        for (int j = 0; j < 4; ++j) { const u32x4 w = pr[64 * j];
            v[j][0] = bf_lo(w.x); v[j][1] = bf_hi(w.x); v[j][2] = bf_lo(w.y); v[j][3] = bf_hi(w.y); v[j][4] = bf_lo(w.z); v[j][5] = bf_hi(w.z); v[j][6] = bf_lo(w.w); v[j][7] = bf_hi(w.w);
            float s = 0.f;
#pragma unroll
            for (int e = 0; e < 8; ++e) s += v[j][e] * v[j][e];
            ss[j] = s; }
        const bool lo = F.lane < 32;
        const float sa = wave_sum(ss[0] + (lo ? ss[1] : 0.f));
        const float sc = wave_sum(ss[3] + (lo ? 0.f : ss[2]));
        float sb = lo ? ss[2] : ss[1];
        sb = group_sum<16>(sb);
        const float ra = rsqrtf(sa * (1.f / 768.f) + RMS_EPS), rc = rsqrtf(sc * (1.f / 768.f) + RMS_EPS), rb = rsqrtf(sb * (1.f / 128.f) + RMS_EPS) * bmul;
#pragma unroll
        for (int j = 0; j < 4; ++j) {
            const int col = j * 512 + F.lane * 8;
            float r; const float* gp;
            if (col < 768) { r = ra; gp = ag + col; } else if (col < 1280) { r = rb; gp = bg + ((col - 768) & 127); } else { r = rc; gp = cgn + (col - 1280); }
            const f32x4 g0 = *(const f32x4*)gp, g1 = *(const f32x4*)(gp + 4);
            u32x4 w; w.x = cvt_pk_bf16(v[j][0] * r * g0.x, v[j][1] * r * g0.y); w.y = cvt_pk_bf16(v[j][2] * r * g0.z, v[j][3] * r * g0.w);
            w.z = cvt_pk_bf16(v[j][4] * r * g1.x, v[j][5] * r * g1.y); w.w = cvt_pk_bf16(v[j][6] * r * g1.z, v[j][7] * r * g1.w);
            pr[64 * j] = w;
        }
    }
}

#undef a
constexpr int N_PHASES = 1 + 12 * DEPTH;

#define PH_IN(k) (lo <= (k) && (k) < hi)

#define XB_TMO      128
#define XB_XCNT(j)  (256  + 64 * (j))
#define XB_XSUB(j)  (1280 + 64 * (j))
#define XB_XGEN(j)  (2304 + 64 * (j))
#define XB_TOP      3328
#define XB_TOPGEN   3392
#define XCD_BAR_WORDS 3456
#define XB_SPIN_CAP (1u << 18)
__device__ __forceinline__ unsigned xb_ld(unsigned* p)              { return __hip_atomic_load(p, __ATOMIC_RELAXED, __HIP_MEMORY_SCOPE_AGENT); }
__device__ __forceinline__ unsigned xb_add(unsigned* p, unsigned v) { return __hip_atomic_fetch_add(p, v, __ATOMIC_RELAXED, __HIP_MEMORY_SCOPE_AGENT); }
__device__ __forceinline__ unsigned xb_xcc_id() { return (unsigned)__builtin_amdgcn_s_getreg((3 << 11) | 20) & 0xFu; }
#define XB_SPIN(cond, bar) do { unsigned _sp = 0; while (cond) { __builtin_amdgcn_s_sleep(1); \
    if ((++_sp & 255u) == 0u) { if (xb_ld(&(bar)[XB_TMO])) break; if (_sp > XB_SPIN_CAP) { atomicAdd(&(bar)[XB_TMO], 1u); break; } } } } while (0)
struct XcdBarrier { unsigned* bar; unsigned x; volatile LAS unsigned* st; };
__device__ __forceinline__ XcdBarrier xcd_barrier_post(unsigned* bar, volatile LAS unsigned* st) {
    XcdBarrier b; b.bar = bar; b.x = xb_xcc_id(); b.st = st;
    if (threadIdx.x == 0) (void)xb_add(&bar[XB_XCNT(b.x)], 1u);
    return b;
}
__device__ __forceinline__ void xcd_barrier_complete(unsigned* bar, unsigned x, unsigned& nloc, unsigned& nx) {
    const unsigned G = gridDim.x * gridDim.y * gridDim.z;
    unsigned sum, cnt, mine, sp = 0u;
    for (;;) {
        sum = 0u; cnt = 0u; mine = 0u;
#pragma unroll
        for (unsigned j = 0; j < 16; ++j) { const unsigned c = xb_ld(&bar[XB_XCNT(j)]); sum += c; cnt += (c > 0u) ? 1u : 0u; mine = (j == x) ? c : mine; }
        if (sum == G) break;
        __builtin_amdgcn_s_sleep(1);
        if ((++sp & 255u) == 0u) { if (xb_ld(&bar[XB_TMO])) break; if (sp > XB_SPIN_CAP) { atomicAdd(&bar[XB_TMO], 1u); break; } }
    }
    nloc = mine > 0u ? mine : 1u; nx = cnt > 0u ? cnt : 1u;
}
__device__ __forceinline__ void xcd_barrier(const XcdBarrier& b) {
    asm volatile("s_waitcnt vmcnt(0)" ::: "memory");
    __syncthreads();
    if (threadIdx.x == 0) {
        unsigned* bar = b.bar;
        __builtin_amdgcn_s_waitcnt(0);
        unsigned nloc = b.st[0], nx = b.st[1];
        if (nloc == 0u) { xcd_barrier_complete(bar, b.x, nloc, nx); b.st[0] = nloc; b.st[1] = nx; }
        const unsigned old = xb_add(&bar[XB_XSUB(b.x)], 1u);
        const unsigned gen = old / nloc;
        if (old + 1u == (gen + 1u) * nloc) {
            __builtin_amdgcn_fence(__ATOMIC_RELEASE, "agent");
            asm volatile("s_waitcnt vmcnt(0)" ::: "memory");
            const unsigned og = xb_add(&bar[XB_TOP], 1u);
            const unsigned tg = og / nx;
            if (og + 1u == (tg + 1u) * nx) xb_add(&bar[XB_TOPGEN], 1u);
            else XB_SPIN(xb_ld(&bar[XB_TOPGEN]) == tg, bar);
            __builtin_amdgcn_fence(__ATOMIC_ACQUIRE, "agent");
            xb_add(&bar[XB_XGEN(b.x)], 1u);
            asm volatile("s_waitcnt vmcnt(0)" ::: "memory");
        } else {
            XB_SPIN(xb_ld(&bar[XB_XGEN(b.x)]) == gen, bar);
            __builtin_amdgcn_fence(__ATOMIC_ACQUIRE, "agent");
            asm volatile("s_waitcnt vmcnt(0)" ::: "memory");
        }
    }
    __syncthreads();
}
constexpr size_t WS_BAR = 4096;
constexpr int LDS_BARST = LDS_BYTES - 64;

#ifndef PROBE_A
#define PROBE_A -1
#define PROBE_B -1
#endif
#if PROBE_A >= 0
#define PH_STAMP(k) do { if (blockIdx.x == 0 && threadIdx.x == 0) ((unsigned long long*)(ws + WS_SCAL + 1024))[k] = __builtin_amdgcn_s_memrealtime(); } while (0)
#else
#define PH_STAMP(k) do { } while (0)
#endif
#define PH_SYNC(k) do { if (coop && (k) + 1 < hi) { if ((k) == 0) cg::this_grid().sync(); else xcd_barrier(xbar); } PH_STAMP((k) + 1); } while (0)
template <int L>
__device__ __forceinline__ void layer_phases(LAS unsigned char* lds, unsigned char* ws, const float* xin, float* out, int lo, int hi, int coop, const XcdBarrier xbar) {
    constexpr bool last = (L == DEPTH - 1);
    constexpr int mrows_tail = last ? ML : MT;
    constexpr int P0 = 1 + 12 * L;
    unsigned char* wl = ws + WS_W + (size_t)L * WL_STRIDE;
    const float* MOD = (const float*)(ws + WS_MOD) + (size_t)L * 3 * MODW;
    const int G = (int)gridDim.x, bid = (int)blockIdx.x;
    if (PH_IN(P0 + 0)) { if (DUP == 8 && L == 0) { phase_norm(L, 0, MT, 0, 2); xcd_barrier(xbar); } phase_norm(L, 0, MT, L == 0 ? 0 : 11, L == 0 ? 2 : 0); PH_SYNC(P0 + 0); }
    if (PH_IN(P0 + 1)) {
        pg8::Gemm g{(const bf16_t*)(ws + WS_XN), (const bf16_t*)(wl + WO_GU1), MT, 2 * FF, DM};
        pg8::StaticOrder<MT, 2 * FF, DM> S; S.init(G, bid); pg8::EpiSwiglu E{(bf16_t*)(ws + WS_H), FF};
        pg8::gemm_phase(lds, g, S, E);
        if (DUP == 1 && L == 0) { xcd_barrier(xbar); pg8::gemm_phase(lds, g, S, E); }
        PH_SYNC(P0 + 1); }
    if (PH_IN(P0 + 2)) {
        pg8::Gemm g{(const bf16_t*)(ws + WS_H), (const bf16_t*)(wl + WO_D1), MT, DM, FF};
        pg8::SplitTailOrder<ML, MT, DM, FF, 11> S; S.init(G, bid); pg8::EpiResid E{L == 0 ? xin : (const float*)(ws + WS_X), (float*)(ws + WS_X), MOD + 2 * DM, 0.5f};
        if (DUP == 2 && L == 0) { pg8::EpiResid E0 = E; E0.coef = 0.f; pg8::gemm_phase(lds, g, S, E0); xcd_barrier(xbar); }
        pg8::gemm_phase(lds, g, S, E); PH_SYNC(P0 + 2); }
    if (PH_IN(P0 + 3)) { phase_norm(L, 3, MT, 11, L == 0 ? 1 : 0); PH_SYNC(P0 + 3); }
    if (PH_IN(P0 + 4)) {
        pg8::Gemm g{(const bf16_t*)(ws + WS_XN), (const bf16_t*)(wl + WO_IN), MT, INW, DM};
        pg8::StaticOrder<MT, INW, DM> S; S.init(G, bid); pg8::EpiQKV E{(bf16_t*)(ws + WS_P), INW, (const float*)(ws + WS_SCAL + 4096) + L * 768, (LAS float*)(lds + RING_BYTES)};
        pg8::gemm_phase(lds, g, S, E); PH_SYNC(P0 + 4); }
    if (PH_IN(P0 + 6)) { if (DUP == 3 && L == 0) { phase_attn(L, !last, 32); xcd_barrier(xbar); }
        if (DUP >= 5 && DUP <= 7 && L == 0) { phase_attn(L, !last, 32, DUP == 5 ? 0 : (DUP == 6 ? 192 : 448), DUP == 5 ? 192 : (DUP == 6 ? 448 : 640)); xcd_barrier(xbar); } phase_attn(L, !last, 0); PH_SYNC(P0 + 6); }
    if (PH_IN(P0 + 7)) { phase_n3(L, mrows_tail); PH_SYNC(P0 + 7); }
    if (PH_IN(P0 + 8)) {
        pg8::Gemm g{(const bf16_t*)(ws + WS_AO), (const bf16_t*)(wl + WO_OUT), mrows_tail, DM, DM};
        pg8::SplitTailOrder<ML, mrows_tail, DM, DM, 8> S; S.init(G, bid); pg8::EpiResid E{(const float*)(ws + WS_X), (float*)(ws + WS_X), MOD + 5 * DM, 1.f};
        pg8::gemm_phase(lds, g, S, E); PH_SYNC(P0 + 8); }
    if (PH_IN(P0 + 9)) { phase_norm(L, 6, mrows_tail, 8, 0); PH_SYNC(P0 + 9); }
    if (PH_IN(P0 + 10)) {
        pg8::Gemm g{(const bf16_t*)(ws + WS_XN), (const bf16_t*)(wl + WO_GU2), mrows_tail, 2 * FF, DM};
        pg8::StaticOrder<mrows_tail, 2 * FF, DM> S; S.init(G, bid); pg8::EpiSwiglu E{(bf16_t*)(ws + WS_H), FF};
        pg8::gemm_phase(lds, g, S, E); PH_SYNC(P0 + 10); }
    if (PH_IN(P0 + 11)) {
        pg8::Gemm g{(const bf16_t*)(ws + WS_H), (const bf16_t*)(wl + WO_D2), mrows_tail, DM, FF};
        pg8::SplitTailOrder<ML, mrows_tail, DM, FF, 11> S; S.init(G, bid); pg8::EpiResid E{(const float*)(ws + WS_X), last ? out : (float*)(ws + WS_X), MOD + 8 * DM, 0.5f};
        pg8::gemm_phase(lds, g, S, E); PH_SYNC(P0 + 11); }
}

__global__ void __launch_bounds__(NTHR, 2) mega_fwd(Args args) {
    LAS unsigned char* lds = (LAS unsigned char*)lds_raw;
    unsigned char* ws = args.ws;
    const int lo = args.ph_lo, hi = args.ph_hi, coop = args.coop;
    if (threadIdx.x < 16) ((LAS unsigned*)(lds + LDS_BYTES - 64))[threadIdx.x] = 0u;
    __syncthreads();
    XcdBarrier xbar; xbar.bar = (unsigned*)(ws + WS_BAR); xbar.x = 0; xbar.st = (volatile LAS unsigned*)(lds + LDS_BARST);
    if (coop) xbar = xcd_barrier_post((unsigned*)(ws + WS_BAR), (volatile LAS unsigned*)(lds + LDS_BARST));
    PH_STAMP(0);
    if (PH_IN(0)) { phase_prologue(); PH_SYNC(0); }
    layer_phases<0>(lds, ws, args.in[I_X], args.out, lo, hi, coop, xbar);
    layer_phases<1>(lds, ws, args.in[I_X], args.out, lo, hi, coop, xbar);
#if PROBE_A >= 0
    cg::this_grid().sync(); PH_STAMP(N_PHASES);
    if (blockIdx.x == 0 && threadIdx.x == 0) { const unsigned long long* ts = (const unsigned long long*)(ws + WS_SCAL + 1024); args.out[0] += (float)(ts[PROBE_B] - ts[PROBE_A]) * 0.01f; }
#endif
}

extern "C" void kernel_launch(void* const* d_in, const int* in_sizes, int n_in, void* d_out, int out_size, void* d_ws, size_t ws_size, hipStream_t stream) {
    static int grid = 0;
    if (grid == 0) {
        if (n_in != 23 || out_size != ML * DM || ws_size < WS_END) { fprintf(stderr, "kernel_launch: unexpected shapes n_in %d out %d ws %zu\n", n_in, out_size, ws_size); grid = -1; return; }
        int dev = 0, cus = 0, per_cu = 0;
        hipGetDevice(&dev); hipDeviceGetAttribute(&cus, hipDeviceAttributeMultiprocessorCount, dev);
        hipFuncSetAttribute((const void*)mega_fwd, hipFuncAttributeMaxDynamicSharedMemorySize, LDS_BYTES);
        hipOccupancyMaxActiveBlocksPerMultiprocessor(&per_cu, (const void*)mega_fwd, NTHR, LDS_BYTES);
        if (per_cu < 1) per_cu = 1;
        grid = cus * 1;
        (void)hipGetLastError();
    }
    if (grid < 0) return;
    hipMemsetAsync((char*)d_ws + WS_CTL, 0, CTL_ZERO_BYTES, stream);
    Args a{};
    for (int i = 0; i < 23; ++i) a.in[i] = (const float*)d_in[i];
    a.out = (float*)d_out; a.ws = (unsigned char*)d_ws;
#if MK_MULTI
    for (int ph = 0; ph < N_PHASES; ++ph) { a.ph_lo = ph; a.ph_hi = ph + 1; a.coop = 0; hipLaunchKernelGGL(mega_fwd, dim3(grid), dim3(NTHR), LDS_BYTES, stream, a); }
#else
    a.ph_lo = 0; a.ph_hi = N_PHASES; a.coop = 1;
    void* kargs[] = {&a};
    hipError_t e = hipLaunchCooperativeKernel((const void*)mega_fwd, dim3(grid), dim3(NTHR), kargs, LDS_BYTES, stream);
    if (e != hipSuccess) fprintf(stderr, "cooperative launch failed: %s (grid %d)\n", hipGetErrorString(e), grid);
#endif
}
```

```cpp
#include <hip/hip_runtime.h>
#include <hip/hip_cooperative_groups.h>
#include <cstdio>
#include <cstdint>
namespace cg = cooperative_groups;

#ifndef DUP
#define DUP 0
#endif
#ifndef MK_MULTI
#define MK_MULTI 0
#endif

#define GAS __attribute__((address_space(1)))
#define LAS __attribute__((address_space(3)))
typedef unsigned short bf16_t;
typedef short bf16x8 __attribute__((ext_vector_type(8)));
typedef float f32x4 __attribute__((ext_vector_type(4)));
typedef float f32x2 __attribute__((ext_vector_type(2)));
typedef unsigned u32x4 __attribute__((ext_vector_type(4)));
typedef unsigned u32x2 __attribute__((ext_vector_type(2)));

constexpr int DM = 2048, BATCH = 2, SEQ = 4096, DEPTH = 2, GRIDW = 64, CTX = 256, NMOD = 9, FF = 5632;
constexpr int ML = BATCH * SEQ, MC = BATCH * CTX, MT = ML + MC;
constexpr int INW = 5120, MODW = NMOD * DM;
constexpr int OFF_AQ = 0, OFF_AK = 768, OFF_AV = 1024, OFF_BQ = 1280, OFF_BK = 1792, OFF_BV = 2304, OFF_CQ = 2816, OFF_CK = 3584, OFF_CV = 4352;
constexpr float RMS_EPS = 1e-6f;
constexpr int NWAVES = 8, NTHR = 512;

constexpr size_t MiB = 1u << 20;
constexpr size_t WS_CTL = 0, CTL_ZERO_BYTES = 1 * MiB;
constexpr size_t WS_MOD = 65536;
constexpr size_t WS_SCAL = 1 * MiB;
constexpr size_t WS_W = 2 * MiB, WL_STRIDE = 160 * MiB;
constexpr size_t WO_GU1 = 0, WO_D1 = 44 * MiB, WO_IN = 66 * MiB, WO_OUT = 86 * MiB, WO_GU2 = 94 * MiB, WO_D2 = 138 * MiB;
constexpr size_t WS_X = 322 * MiB;
constexpr size_t WS_XN = 390 * MiB;
constexpr size_t WS_H = 424 * MiB;
constexpr size_t WS_P = 518 * MiB;
constexpr size_t WS_AO = 604 * MiB;
constexpr size_t WS_PART = 640 * MiB;
constexpr size_t WS_END = 688 * MiB;
static_assert(WS_MOD + (size_t)DEPTH * 3 * MODW * 4 <= CTL_ZERO_BYTES, "mod inside zero region");
static_assert(WS_X + (size_t)MT * DM * 4 <= WS_XN && WS_XN + (size_t)MT * DM * 2 <= WS_H && WS_H + (size_t)MT * FF * 2 <= WS_P && WS_P + (size_t)MT * INW * 2 <= WS_AO && WS_AO + (size_t)MT * DM * 2 <= WS_END, "ws map");

constexpr int RING_BYTES = 131072, LDS_BYTES = 147456;

__device__ __forceinline__ unsigned cvt_pk_bf16(float lo, float hi) { unsigned r; asm volatile("v_cvt_pk_bf16_f32 %0, %1, %2" : "=v"(r) : "v"(lo), "v"(hi)); return r; }
__device__ __forceinline__ float bf_lo(unsigned u) { return __uint_as_float(u << 16); }
__device__ __forceinline__ float bf_hi(unsigned u) { return __uint_as_float(u & 0xffff0000u); }
template <int CTRL> __device__ __forceinline__ float dpp_f(float v) { return __uint_as_float((unsigned)__builtin_amdgcn_update_dpp(0, (int)__float_as_uint(v), CTRL, 0xf, 0xf, true)); }
template <int NL> __device__ __forceinline__ float group_sum(float v) {
    v += dpp_f<0xB1>(v);
    v += dpp_f<0x4E>(v);
    v += dpp_f<0x141>(v);
    v += dpp_f<0x140>(v);
    if (NL >= 32) v += __uint_as_float((unsigned)__builtin_amdgcn_ds_swizzle((int)__float_as_uint(v), 0x401F));
    if (NL >= 64) { auto rr = __builtin_amdgcn_permlane32_swap(__float_as_uint(v), __float_as_uint(v), false, false); v = __uint_as_float(rr[0]) + __uint_as_float(rr[1]); }
    return v;
}
__device__ __forceinline__ float wave_sum(float v) { return group_sum<64>(v); }
__device__ __forceinline__ float silu_f(float v) { return v / (1.f + __expf(-v)); }
__device__ __forceinline__ void sincos_small(float x, float& s, float& c) {
    const float k = rintf(x * 0.636619772f);
    float r = fmaf(-k, 1.57079637e+0f, x); r = fmaf(-k, -4.37113883e-8f, r);
    const float r2 = r * r;
    float sp = fmaf(r2, 2.7557319e-6f, -1.9841270e-4f); sp = fmaf(sp, r2, 8.3333333e-3f); sp = fmaf(sp, r2, -1.6666667e-1f); sp = fmaf(sp * r2, r, r);
    float cp = fmaf(r2, 2.4801587e-5f, -1.3888889e-3f); cp = fmaf(cp, r2, 4.1666667e-2f); cp = fmaf(cp, r2, -0.5f); cp = fmaf(cp, r2, 1.f);
    const int q = ((int)k) & 3;
    const float ss = (q & 1) ? cp : sp, cc = (q & 1) ? sp : cp;
    s = (q & 2) ? -ss : ss;
    c = ((q + 1) & 2) ? -cc : cc;
}

namespace pg8 {
constexpr int BM = 256, BK = 64, HALF = 128, HTB = HALF * BK * 2, STAGE_BYTES = 8 * HTB, NXCD = 8, WGM = 8;
__host__ __device__ __forceinline__ int lds_byte(int r, int c) { const int st = (r >> 4) * 2 + (c >> 5), rr = r & 15, cc = c & 31, ob = rr * 64 + cc * 2; return st * 1024 + (ob ^ (((ob >> 9) & 1) << 5)); }
__host__ __device__ __forceinline__ void stage_rc(int b, int& R, int& C) { const int st = b / 1024, sb = b % 1024, swz = sb ^ (((sb >> 9) & 1) << 5); R = (st >> 1) * 16 + swz / 64; C = (st & 1) * 32 + (swz % 64) / 2; }
__host__ __device__ __forceinline__ int perm32(int rho) { const int n = rho >> 4, i = rho & 15; return 8 * (i >> 2) + 4 * n + (i & 3); }
struct Unit { int pm, pn, k0, nt, atomic; };
struct Gemm { const bf16_t* A; const bf16_t* Bt; int M, N, K; };
template <int M, int N, int K, int WGM_ = WGM>
struct StaticOrder {
    static constexpr int nM = M / BM, nN = N / BM, nwg = nM * nN, ntk = K / BK;
    int G, c;
    __device__ __forceinline__ void init(int G_, int c_) { G = G_; c = c_; }
    __device__ __forceinline__ void map(int L, int& pm, int& pn) const {
        int wgid = L; { constexpr int q = nwg / NXCD, r = nwg % NXCD; const int xcd = wgid % NXCD, off = wgid / NXCD; wgid = (xcd < r ? xcd * (q + 1) : r * (q + 1) + (xcd - r) * q) + off; }
        constexpr int nig = WGM_ * nN; const int gid = wgid / nig, fm = gid * WGM_, gsz = (nM - fm) < WGM_ ? (nM - fm) : WGM_;
        pm = fm + ((wgid % nig) % gsz); pn = (wgid % nig) / gsz;
    }
    __device__ __forceinline__ bool next(int i, Unit& u) const {
        const int L = i * G + c; if (L >= nwg) return false;
        int pm, pn; map(L, pm, pn);
        u.pm = pm; u.pn = pn; u.k0 = 0; u.nt = ntk; u.atomic = 0; return true;
    }
};
template <int MLAT, int MTOT, int N, int K, int KS>
struct SplitTailOrder {
    StaticOrder<MLAT, N, K, 4> lat;
    static constexpr int nlat = (MLAT / BM) * (N / BM), nN = N / BM, pm0 = MLAT / BM, ntail = ((MTOT - MLAT) / BM) * nN * KS, ntk_sub = K / BK / KS;
    static_assert(KS == 1 || (K / BK) % (2 * KS) == 0, "split-K pieces need an even number of K tiles");
    __device__ __forceinline__ void init(int G_, int c_) { lat.init(G_, c_); }
    __device__ __forceinline__ bool next(int i, Unit& u) const {
        const int L = i * lat.G + lat.c;
        if (L >= nlat + ntail) return false;
        const bool tail = L >= nlat;
        int pml, pnl; lat.map(tail ? 0 : L, pml, pnl);
        const int s = tail ? L - nlat : 0, un = s / KS, ks = s % KS;
        u.pm = tail ? pm0 + un / nN : pml; u.pn = tail ? un % nN : pnl; u.nt = tail ? ntk_sub : K / BK; u.k0 = tail ? ks * ntk_sub * BK : 0; u.atomic = tail ? ks + 1 : 0;
        return true;
    }
};

struct EpiBf16 {
    static constexpr bool PERM = true;
    bf16_t* O; int ldc;
    __device__ __forceinline__ void operator()(const f32x4 (&acc)[2][2][4][2], const Unit& u, int wr, int wc, int fr, int fq) const {
        const int row0 = u.pm * BM + wr * 64 + fr, col0 = u.pn * BM + wc * 32 + 8 * fq;
#pragma unroll
        for (int ai = 0; ai < 2; ++ai)
#pragma unroll
            for (int m = 0; m < 4; ++m) { bf16_t* rowp = O + (size_t)(row0 + ai * HALF + m * 16) * ldc + col0;
#pragma unroll
                for (int bj = 0; bj < 2; ++bj) { const f32x4 v0 = acc[ai][bj][m][0], v1 = acc[ai][bj][m][1];
                    u32x4 w; w.x = cvt_pk_bf16(v0[0], v0[1]); w.y = cvt_pk_bf16(v0[2], v0[3]); w.z = cvt_pk_bf16(v1[0], v1[1]); w.w = cvt_pk_bf16(v1[2], v1[3]);
                    *(u32x4*)(rowp + bj * HALF) = w; } }
    }
};
__host__ __device__ __forceinline__ int qk_pos128(int d) { const int n = (d >> 5) & 1, q = (d & 31) + ((d >> 6) << 5); return 32 * (q >> 4) + 8 * ((q >> 2) & 3) + 4 * n + (q & 3); }
__host__ __device__ __forceinline__ int qk_pos64(int d)  { const int n = (d >> 4) & 1, q = (d & 15) + ((d >> 5) << 4); return 32 * (q >> 4) + 8 * ((q >> 2) & 3) + 4 * n + (q & 3); }
__host__ __device__ __forceinline__ int win_dest_row(int n) {
    const bool p128 = (n < 1024) || (n >= 2816 && n < 4352), p64 = (n >= 1280 && n < 2304);
    return p128 ? (n & ~127) + qk_pos128(n & 127) : (p64 ? (n & ~63) + qk_pos64(n & 63) : n);
}
struct EpiQKV {
    static constexpr bool PERM = true;
    bf16_t* O; int ldc; const float* gt; LAS float* red;
    __device__ __forceinline__ void operator()(const f32x4 (&acc)[2][2][4][2], const Unit& u, int wr, int wc, int fr_, int fq_) const {
        int fr = fr_, fq = fq_; asm volatile("" : "+v"(fr), "+v"(fq));
        const int pn = u.pn;
        const bool isv = (pn == 4) || (pn == 9) || (pn == 10) || (pn >= 17);
        if (!isv) {
            const bool hd64 = (pn >= 5 && pn <= 8);
            const bool rope = (pn <= 8) && (u.pm < 32);
            const int gidx = pn <= 2 ? 0 : (pn == 3 ? 1 : (pn <= 6 ? 2 : (pn <= 8 ? 3 : (pn <= 13 ? 4 : 5))));
            const float* gain = gt + gidx * 128;
#pragma unroll
            for (int ai = 0; ai < 2; ++ai)
#pragma unroll
                for (int m = 0; m < 4; ++m)
#pragma unroll
                    for (int bj = 0; bj < 2; ++bj) {
                        const f32x4 a0 = acc[ai][bj][m][0], a1 = acc[ai][bj][m][1];
                        float sq = (a0[0] * a0[0] + a0[1] * a0[1]) + (a0[2] * a0[2] + a0[3] * a0[3]) + (a1[0] * a1[0] + a1[1] * a1[1]) + (a1[2] * a1[2] + a1[3] * a1[3]);
                        sq += __uint_as_float((unsigned)__builtin_amdgcn_ds_swizzle((int)__float_as_uint(sq), 0x401F));
                        { auto rr = __builtin_amdgcn_permlane32_swap(__float_as_uint(sq), __float_as_uint(sq), false, false); sq = __uint_as_float(rr[0]) + __uint_as_float(rr[1]); }
                        if (fq == 0) red[((ai * HALF + wr * 64 + m * 16 + fr) * 2 + bj) * 4 + wc] = sq;
                    }
            asm volatile("s_waitcnt lgkmcnt(0)" ::: "memory"); __builtin_amdgcn_s_barrier(); asm volatile("" ::: "memory");
            const int g = hd64 ? 4 * (wc & 1) + fq : 4 * wc + fq;
            int dimb[4]; float frq[4]; bool usecol[4];
#pragma unroll
            for (int j = 0; j < 4; ++j) { const int q = 4 * g + j;
                if (hd64) { dimb[j] = q + (q >= 16 ? 16 : 0); usecol[j] = q >= 16; frq[j] = exp2f(-(float)(q & 15) * (13.287712379549449f / 16.f)); }
                else      { dimb[j] = q + (q >= 32 ? 32 : 0); usecol[j] = q >= 32; frq[j] = exp2f(-(float)(q & 31) * (13.287712379549449f / 32.f)); } }
            const int dn = hd64 ? 16 : 32;
            float g0[4], g1[4];
#pragma unroll
            for (int j = 0; j < 4; ++j) { g0[j] = gain[dimb[j]]; g1[j] = gain[dimb[j] + dn]; }
#pragma unroll
            for (int ai = 0; ai < 2; ++ai)
#pragma unroll
                for (int m = 0; m < 4; ++m) {
                    const int rl = ai * HALF + wr * 64 + m * 16 + fr, row = u.pm * BM + rl;
                    const int tt = row & (SEQ - 1); const float prow = (float)(tt >> 6), pcol = (float)(tt & 63);
                    float sn[4], cs[4];
                    if (rope) {
#pragma unroll
                        for (int j = 0; j < 4; ++j) sincos_small((usecol[j] ? pcol : prow) * frq[j], sn[j], cs[j]);
                    }
                    bf16_t* rowp = O + (size_t)row * ldc + u.pn * BM + wc * 32 + 8 * fq;
#pragma unroll
                    for (int bj = 0; bj < 2; ++bj) {
                        const f32x4 pp = *(const LAS f32x4*)(red + (rl * 2 + bj) * 4);
                        const float tot = hd64 ? ((wc & 2) ? pp[2] + pp[3] : pp[0] + pp[1]) : (pp[0] + pp[1]) + (pp[2] + pp[3]);
                        const float rstd = rsqrtf(tot * (hd64 ? 1.f / 64.f : 1.f / 128.f) + RMS_EPS);
                        float ya[4], yb[4];
#pragma unroll
                        for (int j = 0; j < 4; ++j) {
                            ya[j] = acc[ai][bj][m][0][j] * rstd * g0[j]; yb[j] = acc[ai][bj][m][1][j] * rstd * g1[j];
                            if (rope) { const float ta = ya[j] * cs[j] - yb[j] * sn[j], tb = ya[j] * sn[j] + yb[j] * cs[j]; ya[j] = ta; yb[j] = tb; }
                        }
                        u32x4 w; w.x = cvt_pk_bf16(ya[0], ya[1]); w.y = cvt_pk_bf16(ya[2], ya[3]); w.z = cvt_pk_bf16(yb[0], yb[1]); w.w = cvt_pk_bf16(yb[2], yb[3]);
                        *(u32x4*)(rowp + bj * HALF) = w;
                    }
                    __builtin_amdgcn_sched_barrier(0);
                }
            return;
        }
        const int row0 = u.pm * BM + wr * 64 + fr, col0 = u.pn * BM + wc * 32 + 8 * fq;
#pragma unroll
        for (int ai = 0; ai < 2; ++ai)
#pragma unroll
            for (int m = 0; m < 4; ++m) { bf16_t* rowp = O + (size_t)(row0 + ai * HALF + m * 16) * ldc + col0;
#pragma unroll
                for (int bj = 0; bj < 2; ++bj) { const f32x4 v0 = acc[ai][bj][m][0], v1 = acc[ai][bj][m][1];
                    u32x4 w; w.x = cvt_pk_bf16(v0[0], v0[1]); w.y = cvt_pk_bf16(v0[2], v0[3]); w.z = cvt_pk_bf16(v1[0], v1[1]); w.w = cvt_pk_bf16(v1[2], v1[3]);
                    *(u32x4*)(rowp + bj * HALF) = w; } }
    }
};
struct EpiSwiglu {
    static constexpr bool PERM = true;
    bf16_t* O; int ldc;
    __device__ __forceinline__ void operator()(const f32x4 (&acc)[2][2][4][2], const Unit& u, int wr, int wc, int fr, int fq) const {
        const int row0 = u.pm * BM + wr * 64 + fr, col0 = u.pn * HALF + wc * 32 + 8 * fq;
#pragma unroll
        for (int ai = 0; ai < 2; ++ai)
#pragma unroll
            for (int m = 0; m < 4; ++m) { bf16_t* rowp = O + (size_t)(row0 + ai * HALF + m * 16) * ldc + col0;
                float h[8];
#pragma unroll
                for (int n = 0; n < 2; ++n)
#pragma unroll
                    for (int j = 0; j < 4; ++j) { const float g = acc[ai][0][m][n][j], up = acc[ai][1][m][n][j]; h[n * 4 + j] = g * __builtin_amdgcn_rcpf(1.f + __expf(-g)) * up; }
                u32x4 w; w.x = cvt_pk_bf16(h[0], h[1]); w.y = cvt_pk_bf16(h[2], h[3]); w.z = cvt_pk_bf16(h[4], h[5]); w.w = cvt_pk_bf16(h[6], h[7]);
                *(u32x4*)rowp = w; }
    }
};
struct EpiResid {
    static constexpr bool PERM = false;
    const float* Xin; float* Xout; const float* gate; float coef;
    __device__ __forceinline__ void operator()(const f32x4 (&acc)[2][2][4][2], const Unit& u, int wr, int wc, int fr, int fq) const {
        const int grp = u.pm < 16 ? 0 : (u.pm < 32 ? 1 : 2);
        const float* gp = gate + (size_t)grp * MODW;
        const int col0 = u.pn * BM + wc * 32 + 4 * fq;
        f32x4 gv[2][2];
#pragma unroll
        for (int bj = 0; bj < 2; ++bj)
#pragma unroll
            for (int n = 0; n < 2; ++n) gv[bj][n] = *(const f32x4*)(gp + col0 + bj * HALF + n * 16) * coef;
#pragma unroll
        for (int ai = 0; ai < 2; ++ai)
#pragma unroll
            for (int m = 0; m < 4; ++m) { const size_t off = (size_t)(u.pm * BM + ai * HALF + wr * 64 + m * 16 + fr) * DM + col0;
#pragma unroll
                for (int bj = 0; bj < 2; ++bj)
#pragma unroll
                    for (int n = 0; n < 2; ++n) {
                        if (u.atomic) { float* part = (float*)((char*)Xout + (WS_PART - WS_X)); *(f32x4*)(part + (size_t)(u.atomic - 1) * MC * DM + (off - (size_t)ML * DM) + bj * HALF + n * 16) = gv[bj][n] * acc[ai][bj][m][n]; }
                        else { const f32x4 xi = *(const f32x4*)(Xin + off + bj * HALF + n * 16);
                            *(f32x4*)(Xout + off + bj * HALF + n * 16) = xi + gv[bj][n] * acc[ai][bj][m][n]; } } }
    }
};

template <class Epi, class Sched>
__device__ __forceinline__ void gemm_phase(LAS unsigned char* lds, const Gemm g, const Sched& S, const Epi& E) {
    const int tid = threadIdx.x, wid = __builtin_amdgcn_readfirstlane(tid >> 6), lane = tid & 63, wr = wid >> 2, wc = wid & 3, fr = lane & 15, fq = lane >> 4;
    const int K = g.K;
    unsigned voffA[2], voffB[2];
#pragma unroll
    for (int i = 0; i < 2; ++i) { int R, C; stage_rc(tid * 16 + i * 8192, R, C); const int Rb = Epi::PERM ? ((R & ~31) + perm32(R & 31)) : R;
        voffA[i] = (unsigned)(R * K + C) * 2u; voffB[i] = (unsigned)(Rb * K + C) * 2u; }
    const size_t kstep = (size_t)(BK * 2);
    const size_t hstep = (size_t)HALF * K * 2;
    const size_t tstep = 2 * hstep;
    const unsigned ldsw = (unsigned)wid * 1024u;
    const int aoff = lds_byte(wr * 64 + fr, fq * 8), boff = lds_byte(wc * 32 + fr, fq * 8);
#define PG8_SA(b, h) (((b) * 2 + (h)) * HTB)
#define PG8_SB(b, h) ((4 + (b) * 2 + (h)) * HTB)
#define PG8_STAGE(bufoff, gbase, voff) do { _Pragma("unroll") for (int _i = 0; _i < 2; ++_i) \
        __builtin_amdgcn_global_load_lds((const unsigned*)((const char*)(gbase) + (voff)[_i]), (LAS unsigned*)(lds + (bufoff) + ldsw + _i * 8192), 16, 0, 0); } while (0)
#define PG8_LDA(dst, b, h) do { _Pragma("unroll") for (int m = 0; m < 4; ++m) _Pragma("unroll") for (int k = 0; k < 2; ++k) dst[m][k] = *(const LAS bf16x8*)(lds + PG8_SA(b, h) + aoff + m * 2048 + k * 1024); } while (0)
#define PG8_LDB(dst, b, h) do { _Pragma("unroll") for (int n = 0; n < 2; ++n) _Pragma("unroll") for (int k = 0; k < 2; ++k) dst[n][k] = *(const LAS bf16x8*)(lds + PG8_SB(b, h) + boff + n * 2048 + k * 1024); } while (0)
#define PG8_MMA(ai, bj, At, Bt) do { __builtin_amdgcn_s_setprio(1); _Pragma("unroll") for (int m = 0; m < 4; ++m) _Pragma("unroll") for (int n = 0; n < 2; ++n) _Pragma("unroll") for (int k = 0; k < 2; ++k) \
        acc[ai][bj][m][n] = __builtin_amdgcn_mfma_f32_16x16x32_bf16(Bt[n][k], At[m][k], acc[ai][bj][m][n], 0, 0, 0); __builtin_amdgcn_s_setprio(0); } while (0)
#define PG8_WAIT_V(n) asm volatile("s_waitcnt vmcnt(" #n ")" ::: "memory")
#define PG8_WAIT_L(n) asm volatile("s_waitcnt lgkmcnt(" #n ")" ::: "memory")
#define PG8_BAR __builtin_amdgcn_s_barrier()
#define PG8_SCHED __builtin_amdgcn_sched_barrier(0)
    Unit cur, nxt; int ui = 0;
    if (!S.next(0, cur)) return;
    f32x4 acc[2][2][4][2];
#pragma unroll
    for (int a = 0; a < 2; ++a)
#pragma unroll
        for (int b = 0; b < 2; ++b)
#pragma unroll
            for (int m = 0; m < 4; ++m)
#pragma unroll
                for (int n = 0; n < 2; ++n) acc[a][b][m][n] = (f32x4){0.f, 0.f, 0.f, 0.f};
    bf16x8 At[4][2], B0[2][2], B1[2][2];
    const char* cA = (const char*)g.A + (size_t)cur.pm * tstep + (size_t)cur.k0 * 2; const char* cB = (const char*)g.Bt + (size_t)cur.pn * tstep + (size_t)cur.k0 * 2;
    PG8_STAGE(PG8_SB(0, 0), cB, voffB); PG8_STAGE(PG8_SB(0, 1), cB + hstep, voffB); PG8_STAGE(PG8_SA(0, 0), cA, voffA); PG8_STAGE(PG8_SA(0, 1), cA + hstep, voffA);
    if (wr == 1) PG8_BAR;
    PG8_WAIT_V(2); PG8_BAR;
    PG8_STAGE(PG8_SB(1, 0), cB + kstep, voffB); PG8_STAGE(PG8_SA(1, 0), cA + kstep, voffA); PG8_STAGE(PG8_SB(1, 1), cB + hstep + kstep, voffB);
    PG8_WAIT_V(6); PG8_BAR;
    for (;;) {
        const bool has_next = S.next(ui + 1, nxt);
        const char* nA = has_next ? (const char*)g.A + (size_t)nxt.pm * tstep + (size_t)nxt.k0 * 2 : cA; const char* nB = has_next ? (const char*)g.Bt + (size_t)nxt.pn * tstep + (size_t)nxt.k0 * 2 : cB;
        const int nt = cur.nt;
        for (int t = 0; t < nt; t += 2) {
            const bool last = (t == nt - 2);
            const char* a1 = cA + (size_t)(t + 1) * kstep;
            const char* a2 = last ? nA : cA + (size_t)(t + 2) * kstep; const char* b2 = last ? nB : cB + (size_t)(t + 2) * kstep;
            const char* a3 = a2 + kstep; const char* b3 = b2 + kstep;
            PG8_LDB(B0, 0, 0); PG8_LDB(B1, 0, 1); PG8_SCHED; PG8_LDA(At, 0, 0); PG8_STAGE(PG8_SA(1, 1), a1 + hstep, voffA);
            PG8_WAIT_V(8); PG8_WAIT_L(0); PG8_BAR; PG8_MMA(0, 0, At, B0); PG8_MMA(0, 1, At, B1); PG8_BAR; PG8_SCHED;
            PG8_LDA(At, 0, 1); PG8_STAGE(PG8_SB(0, 0), b2, voffB); PG8_STAGE(PG8_SB(0, 1), b2 + hstep, voffB); PG8_STAGE(PG8_SA(0, 0), a2, voffA);
            PG8_WAIT_V(8); PG8_WAIT_L(0); PG8_BAR; PG8_MMA(1, 0, At, B0); PG8_MMA(1, 1, At, B1); PG8_BAR; PG8_SCHED;
            PG8_LDB(B0, 1, 0); PG8_LDB(B1, 1, 1); PG8_SCHED; PG8_LDA(At, 1, 0); PG8_STAGE(PG8_SA(0, 1), a2 + hstep, voffA);
            PG8_WAIT_V(8); PG8_WAIT_L(0); PG8_BAR; PG8_MMA(0, 0, At, B0); PG8_MMA(0, 1, At, B1); PG8_BAR; PG8_SCHED;
            PG8_LDA(At, 1, 1); PG8_STAGE(PG8_SB(1, 0), b3, voffB); PG8_STAGE(PG8_SB(1, 1), b3 + hstep, voffB); PG8_STAGE(PG8_SA(1, 0), a3, voffA);
            PG8_WAIT_V(8); PG8_WAIT_L(0); PG8_BAR; PG8_MMA(1, 0, At, B0); PG8_MMA(1, 1, At, B1); PG8_BAR; PG8_SCHED;
        }
        if (wr == 0) PG8_BAR;
        E(acc, cur, wr, wc, fr, fq);
        if (!has_next) break;
#pragma unroll
        for (int a = 0; a < 2; ++a)
#pragma unroll
            for (int b = 0; b < 2; ++b)
#pragma unroll
                for (int m = 0; m < 4; ++m)
#pragma unroll
                    for (int n = 0; n < 2; ++n) acc[a][b][m][n] = (f32x4){0.f, 0.f, 0.f, 0.f};
        cur = nxt; cA = nA; cB = nB; ++ui;
        if (wr == 1) PG8_BAR;
    }
    PG8_WAIT_V(0);
    PG8_BAR;
#undef PG8_SA
#undef PG8_SB
#undef PG8_STAGE
#undef PG8_LDA
#undef PG8_LDB
#undef PG8_MMA
#undef PG8_WAIT_V
#undef PG8_WAIT_L
#undef PG8_BAR
#undef PG8_SCHED
}
}

struct Args { const float* in[23]; float* out; unsigned char* ws; int ph_lo, ph_hi, coop, pad; };
enum { I_X = 0, I_C, I_CTX, I_CCTX, I_WMOD, I_BMOD, I_F1GU, I_F1D, I_F2GU, I_F2D, I_WIN, I_WOUT, I_AQG, I_AKG, I_AOG, I_BQG, I_BKG, I_BLAM, I_BOG, I_CQG, I_CKG, I_CRB, I_COG };

typedef const __attribute__((address_space(4))) Args* KArgs;
__device__ __forceinline__ KArgs get_args() { KArgs p = (KArgs)__builtin_amdgcn_kernarg_segment_ptr(); asm volatile("" : "+s"(p)); return p; }

struct Ctx {
    LAS unsigned char* lds; int tid, lane, wave, G, gw, NGW;
    unsigned char* ws;
};
extern __shared__ __attribute__((aligned(16))) unsigned char lds_raw[];
__device__ __forceinline__ Ctx make_ctx(KArgs ap) {
    Ctx F; int tid = threadIdx.x, bid = blockIdx.x, G = gridDim.x;
    asm volatile("" : "+v"(tid)); asm volatile("" : "+s"(bid)); asm volatile("" : "+s"(G));
    F.lds = (LAS unsigned char*)lds_raw; F.tid = tid; F.lane = tid & 63; F.wave = __builtin_amdgcn_readfirstlane(tid >> 6);
    F.G = G; F.gw = bid * NWAVES + F.wave; F.NGW = G * NWAVES; F.ws = ap->ws;
    return F;
}

__device__ __forceinline__ void transpose_item(const float* W, int K, int N, bf16_t* WT, int k0, int n0, int drow0, LAS float* scr, int lane) {
#pragma unroll 8
    for (int i = 0; i < 32; ++i) { const int kk = 2 * i + (lane >> 5); scr[kk * 33 + (lane & 31)] = W[(size_t)(k0 + kk) * N + n0 + (lane & 31)]; }
    asm volatile("s_waitcnt lgkmcnt(0)" ::: "memory");
    const int c = lane & 7;
#pragma unroll
    for (int j = 0; j < 4; ++j) { const int n = (lane >> 3) + 8 * j; const LAS float* s = scr + (8 * c) * 33 + n;
        u32x4 o; o.x = cvt_pk_bf16(s[0 * 33], s[1 * 33]); o.y = cvt_pk_bf16(s[2 * 33], s[3 * 33]); o.z = cvt_pk_bf16(s[4 * 33], s[5 * 33]); o.w = cvt_pk_bf16(s[6 * 33], s[7 * 33]);
        *(u32x4*)(WT + (size_t)(drow0 + n) * K + k0 + 8 * c) = o; }
    asm volatile("s_waitcnt lgkmcnt(0)" ::: "memory");
}

__device__ __forceinline__ void transpose_item64(const float* W, int K, int N, bf16_t* WT, int k0, int n0, int drow0, LAS float* scr, int lane, bool win = false) {
    const int lr = lane >> 4, lc = (lane & 15) * 4;
    f32x4 v[16];
#pragma unroll
    for (int i = 0; i < 16; ++i) v[i] = *(const f32x4*)(W + (size_t)(k0 + 4 * i + lr) * N + n0 + lc);
#pragma unroll
    for (int i = 0; i < 16; ++i) { LAS float* d = scr + (4 * i + lr) * 65 + lc; d[0] = v[i].x; d[1] = v[i].y; d[2] = v[i].z; d[3] = v[i].w; }
    asm volatile("s_waitcnt lgkmcnt(0)" ::: "memory");
    const int c = lane & 7;
#pragma unroll
    for (int j = 0; j < 8; ++j) { const int n = (lane >> 3) + 8 * j; const LAS float* sp = scr + (8 * c) * 65 + n;
        u32x4 o; o.x = cvt_pk_bf16(sp[0 * 65], sp[1 * 65]); o.y = cvt_pk_bf16(sp[2 * 65], sp[3 * 65]); o.z = cvt_pk_bf16(sp[4 * 65], sp[5 * 65]); o.w = cvt_pk_bf16(sp[6 * 65], sp[7 * 65]);
        const int drow = win ? pg8::win_dest_row(n0 + n) : drow0 + n;
        *(u32x4*)(WT + (size_t)drow * K + k0 + 8 * c) = o; }
    asm volatile("s_waitcnt lgkmcnt(0)" ::: "memory");
}

__device__ __forceinline__ void phase_prologue() {
    const KArgs ap = get_args(); Ctx F = make_ctx(ap);
#define a (*ap)
    LAS float* sil = (LAS float*)(F.lds + 73728);
    for (int i = F.tid; i < 3 * DM; i += NTHR) {
        const int g = i / DM, k = i % DM;
        const float v = (g == 0) ? a.in[I_C][k] : (g == 1) ? a.in[I_C][DM + k] : a.in[I_CCTX][k];
        sil[i] = silu_f(v);
    }
    __syncthreads();
    if (F.gw / NWAVES == 1) {
        float* GT = (float*)(F.ws + WS_SCAL + 4096);
        for (int i = F.tid; i < DEPTH * 6 * 128; i += NTHR) { const int l = i / 768, r = i % 768, t = r / 128, d = r % 128;
            const int src = (t == 0) ? I_AQG : (t == 1) ? I_AKG : (t == 2) ? I_BQG : (t == 3) ? I_BKG : (t == 4) ? I_CQG : I_CKG;
            const bool b64 = (t == 2 || t == 3);
            GT[i] = b64 ? (d < 64 ? a.in[src][l * 64 + d] : 0.f) : a.in[src][l * 128 + d]; }
    }
    if (F.gw == 0) {
        for (int l = 0; l < DEPTH; ++l) {
            const float* lv = a.in[I_BLAM] + l * 256;
            const float s1 = wave_sum(lv[F.lane] * lv[64 + F.lane]), s2 = wave_sum(lv[128 + F.lane] * lv[192 + F.lane]);
            const float lam_init = (l == 0) ? 0.2f : 0.35550906f;
            if (F.lane == 0) ((float*)(F.ws + WS_SCAL))[l] = expf(s1) - expf(s2) + lam_init;
        }
    }
    {
        float* MOD = (float*)(F.ws + WS_MOD);
        LAS f32x4* red = (LAS f32x4*)(F.lds + 98304);
        constexpr int NCC = MODW / 256;
        for (int it = F.gw / NWAVES; it < DEPTH * NCC; it += F.G) {
            const int l = it / NCC, cc = it % NCC, col = cc * 256 + F.lane * 4;
            const float* W = a.in[I_WMOD] + (size_t)l * DM * MODW + col;
            f32x4 a0 = {0, 0, 0, 0}, a1 = a0, a2 = a0;
#pragma unroll 16
            for (int k = F.wave * 256; k < (F.wave + 1) * 256; ++k) {
                const f32x4 w = *(const f32x4*)(W + (size_t)k * MODW);
                const float s0 = sil[k], s1 = sil[DM + k], s2 = sil[2 * DM + k];
                a0 += w * s0; a1 += w * s1; a2 += w * s2;
            }
            red[(F.wave * 3 + 0) * 64 + F.lane] = a0; red[(F.wave * 3 + 1) * 64 + F.lane] = a1; red[(F.wave * 3 + 2) * 64 + F.lane] = a2;
            __syncthreads();
            if (F.wave < 3) {
                f32x4 t = *(const f32x4*)(a.in[I_BMOD] + (size_t)l * MODW + col);
#pragma unroll
                for (int w = 0; w < 8; ++w) t += red[(w * 3 + F.wave) * 64 + F.lane];
                *(f32x4*)(MOD + ((size_t)l * 3 + F.wave) * MODW + col) = t;
            }
            __syncthreads();
        }
    }
    __syncthreads();
    {
        constexpr int IT_GU = (DM / 64) * (2 * FF / 64), IT_D = (FF / 64) * (DM / 64), IT_IN = (DM / 64) * (INW / 64), IT_OUT = (DM / 64) * (DM / 64);
        constexpr int IT_L = 2 * IT_GU + 2 * IT_D + IT_IN + IT_OUT, IT_ALL = DEPTH * IT_L;
        LAS float* scr = (LAS float*)(F.lds + F.wave * 16640);
        int it_lo, it_hi, it_step;
        if (F.G == 256) {
            static_assert(IT_ALL == 1152 * 16 + 22528, "transpose item split");
            const int bid = F.gw / NWAVES;
            if (bid < 144) { it_lo = F.gw * 16; it_hi = it_lo + 16; }
            else { const int v = F.gw - 1152; it_lo = 18432 + (v * 176) / 7; it_hi = 18432 + ((v + 1) * 176) / 7; }
            it_step = 1;
        } else { it_lo = F.gw; it_hi = IT_ALL; it_step = F.NGW; }
        for (int rep_ = 0; rep_ < (DUP == 4 ? 2 : 1); ++rep_)
        for (int it = it_lo; it < it_hi; it += it_step) {
            const int l = it / IT_L; int r = it % IT_L;
            unsigned char* wl = F.ws + WS_W + (size_t)l * WL_STRIDE;
            const float* W; int K, N; bf16_t* WT; bool gu = false, win = false;
            if (r < IT_GU) { W = a.in[I_F1GU] + (size_t)l * DM * 2 * FF; K = DM; N = 2 * FF; WT = (bf16_t*)(wl + WO_GU1); gu = true; }
            else if ((r -= IT_GU) < IT_GU) { W = a.in[I_F2GU] + (size_t)l * DM * 2 * FF; K = DM; N = 2 * FF; WT = (bf16_t*)(wl + WO_GU2); gu = true; }
            else if ((r -= IT_GU) < IT_D) { W = a.in[I_F1D] + (size_t)l * FF * DM; K = FF; N = DM; WT = (bf16_t*)(wl + WO_D1); }
            else if ((r -= IT_D) < IT_D) { W = a.in[I_F2D] + (size_t)l * FF * DM; K = FF; N = DM; WT = (bf16_t*)(wl + WO_D2); }
            else if ((r -= IT_D) < IT_IN) { W = a.in[I_WIN] + (size_t)l * DM * INW; K = DM; N = INW; WT = (bf16_t*)(wl + WO_IN); win = true; }
            else { r -= IT_IN; W = a.in[I_WOUT] + (size_t)l * DM * DM; K = DM; N = DM; WT = (bf16_t*)(wl + WO_OUT); }
            const int nblk = N / 64, kb = r / nblk, nb = r % nblk, n0 = 64 * nb;
            int drow0 = n0;
            if (gu) { const int j = (n0 < FF) ? n0 : n0 - FF; drow0 = (j >> 7) * 256 + ((n0 < FF) ? 0 : 128) + (j & 127); }
            transpose_item64(W, K, N, WT, 64 * kb, n0, drow0, scr, F.lane, win);
        }
    }
}

#undef a
__device__ __forceinline__ void phase_norm(int l, int ishift, int nrows, int npart, int srcmode) {
    const KArgs ap = get_args(); Ctx F = make_ctx(ap);
    const float* lat_src = srcmode == 2 ? ap->in[I_X] : (const float*)(F.ws + WS_X);
    const float* ctx_src = srcmode >= 1 ? ap->in[I_CTX] : (const float*)(F.ws + WS_X) + (size_t)ML * DM;
    const float* MOD = (const float*)(F.ws + WS_MOD) + (size_t)l * 3 * MODW;
    const float* X = (const float*)(F.ws + WS_X); bf16_t* XN = (bf16_t*)(F.ws + WS_XN);
    LAS f32x4* msc = (LAS f32x4*)F.lds;
    for (int i = F.tid; i < 3 * 2 * (DM / 4); i += NTHR) { const int g = i / (2 * (DM / 4)), r = i % (2 * (DM / 4)), w = r / (DM / 4), c = r % (DM / 4);
        const f32x4 t = *((const f32x4*)(MOD + (size_t)g * MODW + (ishift + (w ? 0 : 1)) * DM) + c); msc[i] = w ? t : t + 1.f; }
    __syncthreads();
    for (int row0 = (F.gw / NWAVES) + F.G * F.wave; row0 < nrows; row0 += 2 * F.NGW) {
        const int row1 = row0 + F.NGW; const bool has1 = row1 < nrows;
        const int row1c = has1 ? row1 : row0;
        const f32x4* xr0 = (const f32x4*)(row0 < ML ? lat_src + (size_t)row0 * DM : ctx_src + (size_t)(row0 - ML) * DM) + F.lane;
        const f32x4* xr1 = (const f32x4*)(row1c < ML ? lat_src + (size_t)row1c * DM : ctx_src + (size_t)(row1c - ML) * DM) + F.lane;
        f32x4 v0[8], v1[8];
#pragma unroll
        for (int j = 0; j < 8; ++j) v0[j] = xr0[64 * j];
#pragma unroll
        for (int j = 0; j < 8; ++j) v1[j] = xr1[64 * j];
#pragma unroll
        for (int rsel = 0; rsel < 2; ++rsel) {
            const int row = rsel ? row1 : row0; if (rsel && !has1) break;
            f32x4 (&v)[8] = rsel ? v1 : v0;
            const int grp = row < SEQ ? 0 : (row < ML ? 1 : 2);
            float s = 0.f;
            if (row >= ML && npart > 0) {
                const f32x4* pr = (const f32x4*)(F.ws + WS_PART) + (size_t)(row - ML) * (DM / 4) + F.lane;
#pragma unroll 1
                for (int p = 0; p < npart; ++p) {
#pragma unroll
                    for (int j = 0; j < 8; ++j) v[j] += pr[(size_t)p * MC * (DM / 4) + 64 * j]; }
                f32x4* xw = (f32x4*)(F.ws + WS_X + (size_t)row * DM * 4) + F.lane;
#pragma unroll
                for (int j = 0; j < 8; ++j) xw[64 * j] = v[j];
            }
#pragma unroll
            for (int j = 0; j < 8; ++j) s += (v[j].x * v[j].x + v[j].y * v[j].y) + (v[j].z * v[j].z + v[j].w * v[j].w);
            const float rstd = rsqrtf(wave_sum(s) * (1.f / DM) + RMS_EPS);
            const LAS f32x4* sc = msc + (grp * 2 + 0) * (DM / 4) + F.lane; const LAS f32x4* sh = msc + (grp * 2 + 1) * (DM / 4) + F.lane;
            u32x2* o = (u32x2*)(XN + (size_t)row * DM) + F.lane;
#pragma unroll
            for (int j = 0; j < 8; ++j) { const f32x4 y = v[j] * rstd * sc[64 * j] + sh[64 * j]; u32x2 w; w.x = cvt_pk_bf16(y.x, y.y); w.y = cvt_pk_bf16(y.z, y.w); o[64 * j] = w; }
        }
    }
}

template <int HDIM> struct QkMap {
    static constexpr int LPH = HDIM / 4, LPHALF = HDIM / 8;
    int hs, half, ip, a0, b0;
    __device__ __forceinline__ QkMap(int lane) { hs = lane / LPH; const int u = lane % LPH; half = u / LPHALF; ip = u % LPHALF; a0 = half * (HDIM / 2) + 2 * ip; b0 = a0 + HDIM / 4; }
};
template <int HDIM>
__device__ __forceinline__ void qk_compute(unsigned& ua, unsigned& ub, const QkMap<HDIM>& m, const float* gain, bool rope, int prow_pos, int pcol_pos) {
    float xa0 = bf_lo(ua), xa1 = bf_hi(ua), xb0 = bf_lo(ub), xb1 = bf_hi(ub);
    float ss = xa0 * xa0 + xa1 * xa1 + xb0 * xb0 + xb1 * xb1;
    ss = group_sum<QkMap<HDIM>::LPH>(ss);
    const float rstd = rsqrtf(ss * (1.f / HDIM) + RMS_EPS);
    xa0 *= rstd * gain[m.a0]; xa1 *= rstd * gain[m.a0 + 1]; xb0 *= rstd * gain[m.b0]; xb1 *= rstd * gain[m.b0 + 1];
    if (rope) {
        const float pos = (float)(m.half ? pcol_pos : prow_pos);
        constexpr float L2T = 13.287712379549449f;
        const float f0 = exp2f(-(float)(2 * m.ip) * (L2T / (HDIM / 4))), f1 = exp2f(-(float)(2 * m.ip + 1) * (L2T / (HDIM / 4)));
        float s0, c0, s1, c1; sincos_small(pos * f0, s0, c0); sincos_small(pos * f1, s1, c1);
        const float ya0 = xa0 * c0 - xb0 * s0, yb0 = xa0 * s0 + xb0 * c0, ya1 = xa1 * c1 - xb1 * s1, yb1 = xa1 * s1 + xb1 * c1;
        xa0 = ya0; xb0 = yb0; xa1 = ya1; xb1 = yb1;
    }
    ua = cvt_pk_bf16(xa0, xa1); ub = cvt_pk_bf16(xb0, xb1);
}
__device__ __forceinline__ void phase_qk(int l) {
    const KArgs ap = get_args(); Ctx F = make_ctx(ap);
#define a (*ap)
    bf16_t* P = (bf16_t*)(F.ws + WS_P);
    const float* aqg = a.in[I_AQG] + l * 128; const float* akg = a.in[I_AKG] + l * 128;
    const float* bqg = a.in[I_BQG] + l * 64;  const float* bkg = a.in[I_BKG] + l * 64;
    const float* cqg = a.in[I_CQG] + l * 128; const float* ckg = a.in[I_CKG] + l * 128;
    const QkMap<128> m1(F.lane); const QkMap<64> m2(F.lane);
    constexpr int NS = 14;
    constexpr int scol[NS] = {OFF_AQ, OFF_AQ + 256, OFF_AQ + 512, OFF_AK, OFF_BQ, OFF_BQ + 256, OFF_BK, OFF_BK + 256, OFF_CQ, OFF_CQ + 256, OFF_CQ + 512, OFF_CK, OFF_CK + 256, OFF_CK + 512};
    for (int row = (F.gw / NWAVES) + F.G * F.wave; row < MT; row += F.NGW) {
        bf16_t* pr = P + (size_t)row * INW;
        const bool lat = row < ML; const int t = row & (SEQ - 1), rr = t >> 6, cc = t & 63;
        unsigned ua[NS], ub[NS];
#pragma unroll
        for (int s = 0; s < NS; ++s) { const bool isb = (s >= 4 && s < 8);
            const int oa = scol[s] + (isb ? m2.hs * 64 + m2.a0 : m1.hs * 128 + m1.a0), ob = scol[s] + (isb ? m2.hs * 64 + m2.b0 : m1.hs * 128 + m1.b0);
            ua[s] = *(const unsigned*)(pr + oa); ub[s] = *(const unsigned*)(pr + ob); }
#pragma unroll
        for (int s = 0; s < NS; ++s) {
            if (s < 3) qk_compute<128>(ua[s], ub[s], m1, aqg, lat, rr, cc);
            else if (s == 3) qk_compute<128>(ua[s], ub[s], m1, akg, lat, rr, cc);
            else if (s < 6) qk_compute<64>(ua[s], ub[s], m2, bqg, lat, rr, cc);
            else if (s < 8) qk_compute<64>(ua[s], ub[s], m2, bkg, lat, rr, cc);
            else if (s < 11) qk_compute<128>(ua[s], ub[s], m1, cqg, false, rr, cc);
            else qk_compute<128>(ua[s], ub[s], m1, ckg, false, rr, cc);
        }
#pragma unroll
        for (int s = 0; s < NS; ++s) { const bool isb = (s >= 4 && s < 8);
            const int oa = scol[s] + (isb ? m2.hs * 64 + m2.a0 : m1.hs * 128 + m1.a0), ob = scol[s] + (isb ? m2.hs * 64 + m2.b0 : m1.hs * 128 + m1.b0);
            *(unsigned*)(pr + oa) = ua[s]; *(unsigned*)(pr + ob) = ub[s]; }
    }
}

#undef a
struct NaiveAcc { float m, l, o0, o1; };
__device__ __forceinline__ void naive_key(NaiveAcc& A, const bf16_t* P, int krow, int kcol, int vcol, float q0, float q1, float scale, float bias, int lane) {
    const unsigned kk = *(const unsigned*)(P + (size_t)krow * INW + kcol + 2 * lane);
    const float s = wave_sum(q0 * bf_lo(kk) + q1 * bf_hi(kk)) * scale + bias;
    const float mn = fmaxf(A.m, s), al = __expf(A.m - mn), p = __expf(s - mn);
    const unsigned vv = *(const unsigned*)(P + (size_t)krow * INW + vcol + 2 * lane);
    A.l = A.l * al + p; A.o0 = A.o0 * al + p * bf_lo(vv); A.o1 = A.o1 * al + p * bf_hi(vv); A.m = mn;
}
__device__ __forceinline__ void phase_attn_naive(int l, bool with_ctx) {
    const KArgs ap = get_args(); Ctx F = make_ctx(ap);
#define a (*ap)
    const bf16_t* P = (const bf16_t*)(F.ws + WS_P); bf16_t* AO = (bf16_t*)(F.ws + WS_AO);
    const float lam = ((const float*)(F.ws + WS_SCAL))[l];
    const int nrows = with_ctx ? MT : ML;
    const int nitems = nrows * 16;
    for (int it = F.gw; it < nitems; it += F.NGW) {
        int row, hd;
        if (it < ML * 16) { const int b = it / (SEQ * 16), r = it % (SEQ * 16); hd = r / SEQ; row = b * SEQ + r % SEQ; }
        else { const int r0 = it - ML * 16; const int b = r0 / (CTX * 16), r = r0 % (CTX * 16); hd = r / CTX; row = ML + b * CTX + r % CTX; }
        const bool lat = row < ML; const int b = lat ? row / SEQ : (row - ML) / CTX;
        const int t = row & (SEQ - 1), qr = t >> 6, qc = t & 63;
        const int ctx0 = ML + b * CTX, lat0 = b * SEQ;
        float o0, o1;
        if (hd < 6 || hd >= 10) {
            const bool isC = hd >= 10; const int h = isC ? hd - 10 : hd;
            const int qcol = isC ? OFF_CQ + h * 128 : OFF_AQ + h * 128;
            const int kcol = isC ? OFF_CK + h * 128 : OFF_AK + (h / 3) * 128;
            const int vcol = isC ? OFF_CV + h * 128 : OFF_AV + (h / 3) * 128;
            const unsigned qq = *(const unsigned*)(P + (size_t)row * INW + qcol + 2 * F.lane);
            const float q0 = bf_lo(qq), q1 = bf_hi(qq); const float scale = 0.08838834764831845f;
            NaiveAcc A{-1e30f, 0.f, 0.f, 0.f};
            for (int i = 0; i < CTX; ++i) naive_key(A, P, ctx0 + i, kcol, vcol, q0, q1, scale, 0.f, F.lane);
            if (lat) {
                if (!isC) { for (int i = 0; i < SEQ; ++i) naive_key(A, P, lat0 + i, kcol, vcol, q0, q1, scale, 0.f, F.lane); }
                else {
                    const int rs = min(max(qr - 4, 0), 56), cs = min(max(qc - 8, 0), 48);
                    const float* rb = a.in[I_CRB] + ((size_t)l * 6 + h) * 15 * 31;
                    for (int w = 0; w < 128; ++w) { const int kr = rs + (w >> 4), kc = cs + (w & 15);
                        naive_key(A, P, lat0 + kr * 64 + kc, kcol, vcol, q0, q1, scale, rb[(kr - qr + 7) * 31 + (kc - qc + 15)], F.lane); }
                }
            }
            const float il = 1.f / A.l; o0 = A.o0 * il; o1 = A.o1 * il;
        } else {
            const int h = hd - 6; const int vcol = OFF_BV + h * 128; const float scale = 0.125f;
            float r0[2], r1[2];
#pragma unroll 1
            for (int sub = 0; sub < 2; ++sub) {
                const int qcol = OFF_BQ + h * 128 + sub * 64, kcol = OFF_BK + h * 128 + sub * 64;
                const unsigned qq = *(const unsigned*)(P + (size_t)row * INW + qcol + 2 * F.lane);
                const float q0 = F.lane < 32 ? bf_lo(qq) : 0.f, q1 = F.lane < 32 ? bf_hi(qq) : 0.f;
                NaiveAcc A{-1e30f, 0.f, 0.f, 0.f};
                for (int i = 0; i < CTX; ++i) naive_key(A, P, ctx0 + i, kcol, vcol, q0, q1, scale, 0.f, F.lane);
                if (lat) for (int i = 0; i < SEQ; ++i) naive_key(A, P, lat0 + i, kcol, vcol, q0, q1, scale, 0.f, F.lane);
                const float il = 1.f / A.l; r0[sub] = A.o0 * il; r1[sub] = A.o1 * il;
            }
            o0 = r0[0] - lam * r0[1]; o1 = r1[0] - lam * r1[1];
        }
        *(unsigned*)(AO + (size_t)row * DM + hd * 128 + 2 * F.lane) = cvt_pk_bf16(o0, o1);
    }
}

#undef a
namespace fa {
using f32x16 = __attribute__((ext_vector_type(16))) float;
using s16x4 = __attribute__((ext_vector_type(4))) short;
constexpr int D = 128, NW = 8, QBLK = 32, KVBLK = 64, LDK = INW;
constexpr int SHM_V = KVBLK * D * 2, SHM_K = KVBLK * D * 2;
constexpr int NSLOT = 3;
constexpr int OFF_WS = NSLOT * SHM_V + NSLOT * SHM_K, OFF_BIAS = OFF_WS + NW * 64 * 4, OFF_UNIT = OFF_BIAS + 2048;
constexpr float THR = 8.f, NEG = -1e30f;
#define KSWZ(row, colB) ((row) * 256 + ((colB) ^ (((row) & 7) << 4)))
#define SBAR() __builtin_amdgcn_sched_barrier(0)
__device__ __forceinline__ int crow(int r, int hi) { return (r & 3) + 8 * (r >> 2) + 4 * hi; }

template <int MODE> struct Sc { static constexpr float SCALE = (MODE == 1) ? 0.125f : 0.088388347648318440f; };

template <int MODE>
__device__ __forceinline__ void partialSM(f32x16& p0, f32x16& p1, float& m_reg, float& mn, float& alpha) {
  constexpr float SCALE = Sc<MODE>::SCALE, C = SCALE * 1.4426950408889634f;
  float pmax = p0[0];
#pragma unroll
  for (int r = 1; r < 16; ++r) pmax = fmaxf(pmax, p0[r]);
#pragma unroll
  for (int r = 0; r < 16; ++r) pmax = fmaxf(pmax, p1[r]);
  { auto rr = __builtin_amdgcn_permlane32_swap(__float_as_uint(pmax), __float_as_uint(pmax), false, false);
    pmax = fmaxf(__uint_as_float(rr[0]), __uint_as_float(rr[1])); }
  if (__builtin_expect(__all(pmax - m_reg <= THR / SCALE), 1)) { mn = m_reg; alpha = 1.f; }
  else { mn = fmaxf(m_reg, pmax); alpha = __builtin_amdgcn_exp2f((m_reg - mn) * C); m_reg = mn; }
  const float mnC = -mn * C;
#pragma unroll
  for (int r = 0; r < 16; ++r) p0[r] = fmaf(p0[r], C, mnC);
#pragma unroll
  for (int r = 0; r < 16; ++r) p1[r] = fmaf(p1[r], C, mnC);
#pragma unroll
  for (int r = 0; r < 16; ++r) p0[r] = __builtin_amdgcn_exp2f(p0[r]);
}
__device__ __forceinline__ void finishSM(f32x16& p0, f32x16& p1, float alpha, float& l_reg, bf16x8& pa0, bf16x8& pa1, bf16x8& pa2, bf16x8& pa3) {
#pragma unroll
  for (int r = 0; r < 16; ++r) p1[r] = __builtin_amdgcn_exp2f(p1[r]);
  float ps = 0;
#pragma unroll
  for (int r = 0; r < 16; ++r) ps += p0[r];
#pragma unroll
  for (int r = 0; r < 16; ++r) ps += p1[r];
  { auto rr = __builtin_amdgcn_permlane32_swap(__float_as_uint(ps), __float_as_uint(ps), false, false);
    ps = __uint_as_float(rr[0]) + __uint_as_float(rr[1]); }
  l_reg = l_reg * alpha + ps;
#define PK4(P, BASE, OUT) do { unsigned a0 = cvt_pk_bf16(P[BASE + 0], P[BASE + 1]), a1 = cvt_pk_bf16(P[BASE + 2], P[BASE + 3]);   \
    unsigned b0 = cvt_pk_bf16(P[BASE + 4], P[BASE + 5]), b1 = cvt_pk_bf16(P[BASE + 6], P[BASE + 7]);                              \
    auto r0 = __builtin_amdgcn_permlane32_swap(a0, b0, false, false); auto r1 = __builtin_amdgcn_permlane32_swap(a1, b1, false, false); \
    u32x4 w = {r0[0], r1[0], r0[1], r1[1]}; OUT = *reinterpret_cast<bf16x8*>(&w); } while (0)
  PK4(p0, 0, pa0); PK4(p0, 8, pa1); PK4(p1, 0, pa2); PK4(p1, 8, pa3);
#undef PK4
}
template <int ND0>
__device__ __forceinline__ void qkt(f32x16& p0, f32x16& p1, const char* Ks0, const bf16x8* qr, int r32, int hi, int kcb) {
  p0 = f32x16{}; p1 = f32x16{};
  const char* Ks = Ks0 + kcb;
#pragma unroll
  for (int d0 = 0; d0 < ND0; ++d0) { const int cb = (d0 * 16 + hi * 8) * 2;
    const bf16x8 b0 = *reinterpret_cast<const bf16x8*>(Ks + KSWZ(r32, cb));
    const bf16x8 b1 = *reinterpret_cast<const bf16x8*>(Ks + KSWZ(32 + r32, cb));
    p0 = __builtin_amdgcn_mfma_f32_32x32x16_bf16(b0, qr[d0], p0, 0, 0, 0);
    p1 = __builtin_amdgcn_mfma_f32_32x32x16_bf16(b1, qr[d0], p1, 0, 0, 0); }
}
__device__ __forceinline__ int v_st(int k, int c) { const int kk = (k & ~0xC) | ((k & 4) << 1) | ((k & 8) >> 1); return ((kk >> 3) * 4 + (c >> 5)) * 512 + ((kk & 7) * 32 + (c & 31)) * 2; }
__device__ __forceinline__ int v_rd_base(int lane) { return ((lane & 3) << 3) | (((lane >> 2) & 3) << 6) | (((lane >> 4) & 1) << 5) | (((lane >> 5) & 1) << 8); }
constexpr int v_rd_off(int d0, int ks, int half) { return d0 * 512 + ks * 4096 + half * 2048; }
template <int OFF> __device__ __forceinline__ s16x4 tr_read(int vb) {
  s16x4 r; asm volatile("ds_read_b64_tr_b16 %0, %1 offset:%2" : "=&v"(r) : "v"(vb), "i"(OFF) : "memory"); return r;
}
template <int D0> __device__ __forceinline__ void pv_one(f32x16& od, int vb, bf16x8 pa0, bf16x8 pa1, bf16x8 pa2, bf16x8 pa3) {
  const s16x4 l0 = tr_read<v_rd_off(D0, 0, 0)>(vb), h0 = tr_read<v_rd_off(D0, 0, 1)>(vb), l1 = tr_read<v_rd_off(D0, 1, 0)>(vb), h1 = tr_read<v_rd_off(D0, 1, 1)>(vb);
  const s16x4 l2 = tr_read<v_rd_off(D0, 2, 0)>(vb), h2 = tr_read<v_rd_off(D0, 2, 1)>(vb), l3 = tr_read<v_rd_off(D0, 3, 0)>(vb), h3 = tr_read<v_rd_off(D0, 3, 1)>(vb);
  asm volatile("s_waitcnt lgkmcnt(0)" ::: "memory"); SBAR();
#define PK(L, H) (bf16x8){L[0], L[1], L[2], L[3], H[0], H[1], H[2], H[3]}
  od = __builtin_amdgcn_mfma_f32_32x32x16_bf16(pa0, PK(l0, h0), od, 0, 0, 0);
  od = __builtin_amdgcn_mfma_f32_32x32x16_bf16(pa1, PK(l1, h1), od, 0, 0, 0);
  od = __builtin_amdgcn_mfma_f32_32x32x16_bf16(pa2, PK(l2, h2), od, 0, 0, 0);
  od = __builtin_amdgcn_mfma_f32_32x32x16_bf16(pa3, PK(l3, h3), od, 0, 0, 0);
#undef PK
}
__device__ __forceinline__ void pv_d0(f32x16* o, int vb, bf16x8 pa0, bf16x8 pa1, bf16x8 pa2, bf16x8 pa3) {
  pv_one<0>(o[0], vb, pa0, pa1, pa2, pa3); pv_one<1>(o[1], vb, pa0, pa1, pa2, pa3); pv_one<2>(o[2], vb, pa0, pa1, pa2, pa3); pv_one<3>(o[3], vb, pa0, pa1, pa2, pa3);
}
__device__ __forceinline__ void cmask(f32x16& p0, f32x16& p1, int kr, int qrow, int qcol, int hi, const float* bias) {
  const int rs = min(max(qrow - 4, 0), 56);
  if (kr < rs || kr >= rs + 8) {
#pragma unroll
    for (int r = 0; r < 16; ++r) { p0[r] = NEG; p1[r] = NEG; }
    return;
  }
  const int cs = min(max(qcol - 8, 0), 48);
  const float* brow = bias + (kr - qrow + 7) * 31 + (15 - qcol);
#pragma unroll
  for (int r = 0; r < 16; ++r) { const int kc = crow(r, hi);
    p0[r] = ((unsigned)(kc - cs) < 16u) ? p0[r] + brow[kc] : NEG;
    p1[r] = ((unsigned)(kc + 32 - cs) < 16u) ? p1[r] + brow[kc + 32] : NEG; }
}

struct Unit { int qrow0, qcol, kcol, vcol, ocol, seg0, seg1, NT, r0, win; float lam; };

template <int MODE>
__device__ __forceinline__ void attn_unit(const bf16_t* __restrict__ P, bf16_t* __restrict__ AO, const Unit u, char* lds) {
  constexpr int ND0 = (MODE == 1) ? 4 : 8;
  int tid = threadIdx.x; asm volatile("" : "+v"(tid));
  const int wid = __builtin_amdgcn_readfirstlane(tid >> 6), lane = tid & 63, r32 = lane & 31, hi = lane >> 5;
  const int sub = (MODE == 1) ? (wid >> 2) : 0, wq = (MODE == 1) ? (wid & 3) : wid;
  char* V_lds = lds; char* K_lds = lds + NSLOT * SHM_V;
  float* wsf = (float*)(lds + OFF_WS) + wid * 64; float* li_l = wsf; float* al_l = wsf + 32;
  const float* bias = (const float*)(lds + OFF_BIAS);
  float m_reg = NEG, l_reg = 0; f32x16 o[4] = {}; bf16x8 qr[ND0];
  const bf16_t* Qw = P + (size_t)(u.qrow0 + wq * QBLK + r32) * INW + u.qcol + sub * 64 + hi * 8;
#pragma unroll
  for (int d0 = 0; d0 < ND0; ++d0) qr[d0] = *reinterpret_cast<const bf16x8*>(Qw + d0 * 16);
  const int kcb = sub * 128;
  const int sr = tid >> 4, sc = (tid & 15) * 8, vst0 = v_st(sr, sc), vst1 = v_st(32 + sr, sc);
  const int vb0 = (int)(uintptr_t)V_lds + v_rd_base(lane);
  const unsigned kgo = (unsigned)((sr * INW + u.kcol + sc) * 2), vgo = (unsigned)((sr * INW + u.vcol + sc) * 2);
  constexpr int SD = (MODE == 2) ? 1 : 2;
  struct { bf16x8 vs0, vs1, ks0, ks1; } sr_[SD];
#define TROW(t) ((size_t)((t) < 4 ? u.seg0 + 64 * (t) : u.seg1 + 64 * ((t) - 4)) * (INW * 2))
#define SLOAD(i, t) do { const char* tb_ = (const char*)P + TROW(t); sr_[i].vs0 = *reinterpret_cast<const bf16x8*>(tb_ + vgo); sr_[i].vs1 = *reinterpret_cast<const bf16x8*>(tb_ + 32 * INW * 2 + vgo); \
    sr_[i].ks0 = *reinterpret_cast<const bf16x8*>(tb_ + kgo); sr_[i].ks1 = *reinterpret_cast<const bf16x8*>(tb_ + 32 * INW * 2 + kgo); } while (0)
#define SWRITE(so, i) do { *(bf16x8*)(V_lds + (so) + vst0) = sr_[i].vs0; *(bf16x8*)(V_lds + (so) + vst1) = sr_[i].vs1; const int kc = sc * 2; \
    *(bf16x8*)(K_lds + (so) + KSWZ(sr, kc)) = sr_[i].ks0; *(bf16x8*)(K_lds + (so) + KSWZ(32 + sr, kc)) = sr_[i].ks1; } while (0)
#define ROT() do { sP = sC; sC = sN; sN = (sN == (NSLOT - 1) * SHM_V) ? 0 : sN + SHM_V; } while (0)
#define SWAIT() do { if (SD == 2) asm volatile("s_waitcnt vmcnt(4)" ::: "memory"); else asm volatile("s_waitcnt vmcnt(0)" ::: "memory"); } while (0)
#define RESC(a) do { if (__any((a) < 1.f)) { if (hi == 0) al_l[r32] = (a); asm volatile("s_waitcnt lgkmcnt(0)" ::: "memory"); \
    _Pragma("unroll") for (int d = 0; d < 4; ++d) _Pragma("unroll") for (int r = 0; r < 16; ++r) o[d][r] *= al_l[crow(r, hi)]; } } while (0)
  const int qrow_g = u.r0 + (wid >> 1), qcol_g = 32 * (wid & 1) + r32;
#define CM(P0, P1, t) do { if (MODE == 2 && u.win && (t) >= 4) cmask(P0, P1, u.seg1 / 64 % 64 + (t) - 4, qrow_g, qcol_g, hi, bias); } while (0)
  f32x16 pA0, pA1, pB0, pB1; float mnA, mnB, alA, alB; bf16x8 pa0, pa1, pa2, pa3; const int NT = u.NT;
  constexpr int SE = 0, SO = SD - 1;
  int sP = 0, sC = 0, sN = SHM_V;
  SLOAD(SE, 0); asm volatile("s_waitcnt vmcnt(0)" ::: "memory"); SWRITE(0, SE); __syncthreads();
  qkt<ND0>(pA0, pA1, K_lds, qr, r32, hi, kcb); partialSM<MODE>(pA0, pA1, m_reg, mnA, alA);
  SLOAD(SO, 1); if (SD == 2 && 2 < NT) SLOAD(SE, 2);
  SWAIT(); SWRITE(SHM_V, SO); __syncthreads();
  sP = 0; sC = SHM_V; sN = 2 * SHM_V;
  for (int j = 1; j + 1 < NT; j += 2) {
    SBAR(); qkt<ND0>(pB0, pB1, K_lds + sC, qr, r32, hi, kcb);
    finishSM(pA0, pA1, alA, l_reg, pa0, pa1, pa2, pa3); SBAR();
    SLOAD(SO, j + SD); SBAR();
    pv_d0(o, vb0 + sP, pa0, pa1, pa2, pa3); CM(pB0, pB1, j); partialSM<MODE>(pB0, pB1, m_reg, mnB, alB);
    SWAIT(); SWRITE(sN, SE);
    RESC(alB); __syncthreads(); ROT();
    SBAR(); qkt<ND0>(pA0, pA1, K_lds + sC, qr, r32, hi, kcb);
    finishSM(pB0, pB1, alB, l_reg, pa0, pa1, pa2, pa3); SBAR();
    if (SD == 1 || j + 3 < NT) SLOAD(SE, j + 1 + SD); SBAR();
    pv_d0(o, vb0 + sP, pa0, pa1, pa2, pa3); CM(pA0, pA1, j + 1); partialSM<MODE>(pA0, pA1, m_reg, mnA, alA);
    SWAIT(); SWRITE(sN, SO);
    RESC(alA); __syncthreads(); ROT();
  }
  SBAR(); qkt<ND0>(pB0, pB1, K_lds + sC, qr, r32, hi, kcb);
  finishSM(pA0, pA1, alA, l_reg, pa0, pa1, pa2, pa3); SBAR();
  pv_d0(o, vb0 + sP, pa0, pa1, pa2, pa3); CM(pB0, pB1, NT - 1); partialSM<MODE>(pB0, pB1, m_reg, mnB, alB);
  RESC(alB);
  finishSM(pB0, pB1, alB, l_reg, pa0, pa1, pa2, pa3); SBAR();
  pv_d0(o, vb0 + sC, pa0, pa1, pa2, pa3);
  if (hi == 0) li_l[r32] = l_reg; asm volatile("s_waitcnt lgkmcnt(0)" ::: "memory");
  float rli[16];
#pragma unroll
  for (int r = 0; r < 16; ++r) rli[r] = __builtin_amdgcn_rcpf(li_l[crow(r, hi)]);
  bf16_t* Ow = AO + (size_t)(u.qrow0 + wq * QBLK) * DM + u.ocol;
  if (MODE == 1) {
    float* X = (float*)lds;
    __syncthreads();
    if (sub == 1) {
#pragma unroll
      for (int d0 = 0; d0 < 4; ++d0)
#pragma unroll
        for (int r = 0; r < 16; ++r) X[((d0 * 16 + r) * 4 + wq) * 64 + lane] = o[d0][r] * rli[r];
    }
    __syncthreads();
    if (sub == 0) {
#pragma unroll
      for (int r = 0; r < 16; ++r) { const int orow = crow(r, hi);
#pragma unroll
        for (int d0 = 0; d0 < 4; ++d0) { const float v = o[d0][r] * rli[r] - u.lam * X[((d0 * 16 + r) * 4 + wq) * 64 + lane];
          Ow[(size_t)orow * DM + d0 * 32 + r32] = (bf16_t)(cvt_pk_bf16(v, 0.f) & 0xffffu); } }
    }
  } else {
#pragma unroll
    for (int r = 0; r < 16; ++r) { const int orow = crow(r, hi);
#pragma unroll
      for (int d0 = 0; d0 < 4; ++d0) Ow[(size_t)orow * DM + d0 * 32 + r32] = (bf16_t)(cvt_pk_bf16(o[d0][r] * rli[r], 0.f) & 0xffffu); }
  }
#undef TROW
#undef SLOAD
#undef SWRITE
#undef ROT
#undef SWAIT
#undef RESC
#undef CM
}
#undef KSWZ
#undef SBAR
}

__device__ __forceinline__ void phase_attn(int l, bool with_ctx, int ctr_off, int u_lo = 0, int u_hi = 100000) {
    const KArgs ap = get_args(); Ctx F = make_ctx(ap);
    const bf16_t* P = (const bf16_t*)(F.ws + WS_P); bf16_t* AO = (bf16_t*)(F.ws + WS_AO);
    unsigned* ctr0 = (unsigned*)(F.ws + WS_CTL) + 256 + l * 256 + ctr_off * 4;
    const float lam = ((const float*)(F.ws + WS_SCAL))[l];
    char* lds = (char*)lds_raw;
    volatile unsigned* uw = (volatile unsigned*)(lds + fa::OFF_UNIT);
    const int NUX = with_ctx ? 85 : 80;
    const int myx = (int)((unsigned)__builtin_amdgcn_s_getreg((3 << 11) | 20) & 7u);
#pragma unroll 1
    for (int qi = 0; qi < 8; ++qi) {
        const int x = (myx + qi) & 7;
        for (;;) {
            __syncthreads();
            if (F.tid == 0) *uw = atomicAdd(ctr0 + 16 * x, 1u);
            __syncthreads();
            const int i = (int)*uw;
            if (i >= NUX) break;
            fa::Unit u; u.lam = lam; u.win = 0; u.r0 = 0; u.seg1 = 0;
            if (i < 32) {
                const int b = x >> 2, h = x & 3, qb = i;
                if (u_lo <= 192 && 192 < u_hi) {
                u.qrow0 = b * SEQ + qb * 128; u.qcol = OFF_BQ + h * 128; u.kcol = OFF_BK + h * 128; u.vcol = OFF_BV + h * 128; u.ocol = 768 + h * 128;
                u.seg0 = ML + b * CTX; u.seg1 = b * SEQ; u.NT = 68;
                fa::attn_unit<1>(P, AO, u, lds); }
            } else if (i < 56) {
                const int st = x >> 1, b = st >> 1, kvh = st & 1, w = (x & 1) * 24 + (i - 32), h = kvh * 3 + w / 16, qb = w % 16;
                if (u_lo <= 0 && 0 < u_hi) {
                u.qrow0 = b * SEQ + qb * 256; u.qcol = OFF_AQ + h * 128; u.kcol = OFF_AK + kvh * 128; u.vcol = OFF_AV + kvh * 128; u.ocol = h * 128;
                u.seg0 = ML + b * CTX; u.seg1 = b * SEQ; u.NT = 68;
                fa::attn_unit<0>(P, AO, u, lds); }
            } else if (i < 80) {
                const int v = x * 24 + (i - 56), b = v / 96, h = (v % 96) / 16, qb = v % 16;
                const int r0 = qb * 4, rbase = min(max(r0 - 4, 0), 52);
                if (u_lo <= 448 && 448 < u_hi) {
                u.qrow0 = b * SEQ + qb * 256; u.qcol = OFF_CQ + h * 128; u.kcol = OFF_CK + h * 128; u.vcol = OFF_CV + h * 128; u.ocol = 1280 + h * 128;
                u.seg0 = ML + b * CTX; u.seg1 = b * SEQ + rbase * 64; u.NT = 16; u.r0 = r0; u.win = 1;
                { const float* rb = ap->in[I_CRB] + ((size_t)l * 6 + h) * 465; float* bl = (float*)(lds + fa::OFF_BIAS);
                  if (F.tid < 465) bl[F.tid] = rb[F.tid] * 11.313708498984761f; }
                fa::attn_unit<2>(P, AO, u, lds); }
            } else if (u_hi > 640) {
                const int v = x * 5 + (i - 80);
                u.NT = 4;
                if (v < 12) { const int b = v / 6, h = v % 6;
                    u.qrow0 = ML + b * CTX; u.qcol = OFF_AQ + h * 128; u.kcol = OFF_AK + (h / 3) * 128; u.vcol = OFF_AV + (h / 3) * 128; u.ocol = h * 128; u.seg0 = ML + b * CTX;
                    fa::attn_unit<0>(P, AO, u, lds);
                } else if (v < 28) { const int w = v - 12, b = w / 8, h = (w % 8) / 2, qb = w % 2;
                    u.qrow0 = ML + b * CTX + qb * 128; u.qcol = OFF_BQ + h * 128; u.kcol = OFF_BK + h * 128; u.vcol = OFF_BV + h * 128; u.ocol = 768 + h * 128; u.seg0 = ML + b * CTX;
                    fa::attn_unit<1>(P, AO, u, lds);
                } else { const int w = v - 28, b = w / 6, h = w % 6;
                    u.qrow0 = ML + b * CTX; u.qcol = OFF_CQ + h * 128; u.kcol = OFF_CK + h * 128; u.vcol = OFF_CV + h * 128; u.ocol = 1280 + h * 128; u.seg0 = ML + b * CTX;
                    fa::attn_unit<0>(P, AO, u, lds);
                }
            }
        }
    }
}

__device__ __forceinline__ void phase_n3(int l, int nrows) {
    const KArgs ap = get_args(); Ctx F = make_ctx(ap);
#define a (*ap)
    bf16_t* AO = (bf16_t*)(F.ws + WS_AO);
    const float* ag = a.in[I_AOG] + l * 768; const float* bg = a.in[I_BOG] + l * 128; const float* cgn = a.in[I_COG] + l * 768;
    const float bmul = 1.f - ((l == 0) ? 0.2f : 0.35550906f);
    for (int row = (F.gw / NWAVES) + F.G * F.wave; row < nrows; row += F.NGW) {
        u32x4* pr = (u32x4*)(AO + (size_t)row * DM) + F.lane;
        float v[4][8]; float ss[4];
#pragma unroll
        for (int j = 0; j < 4; ++j) { const u32x4 w = pr[64 * j];
            v[j][0] = bf_lo(w.x); v[j][1] = bf_hi(w.x); v[j][2] = bf_lo(w.y); v[j][3] = bf_hi(w.y); v[j][4] = bf_lo(w.z); v[j][5] = bf_hi(w.z); v[j][6] = bf_lo(w.w); v[j][7] = bf_hi(w.w);
            float s = 0.f;
#pragma unroll
            for (int e = 0; e < 8; ++e) s += v[j][e] * v[j][e];
            ss[j] = s; }
        const bool lo = F.lane < 32;
        const float sa = wave_sum(ss[0] + (lo ? ss[1] : 0.f));
        const float sc = wave_sum(ss[3] + (lo ? 0.f : ss[2]));
        float sb = lo ? ss[2] : ss[1];
        sb = group_sum<16>(sb);
        const float ra = rsqrtf(sa * (1.f / 768.f) + RMS_EPS), rc = rsqrtf(sc * (1.f / 768.f) + RMS_EPS), rb = rsqrtf(sb * (1.f / 128.f) + RMS_EPS) * bmul;
#pragma unroll
        for (int j = 0; j < 4; ++j) {
            const int col = j * 512 + F.lane * 8;
            float r; const float* gp;
            if (col < 768) { r = ra; gp = ag + col; } else if (col < 1280) { r = rb; gp = bg + ((col - 768) & 127); } else { r = rc; gp = cgn + (col - 1280); }
            const f32x4 g0 = *(const f32x4*)gp, g1 = *(const f32x4*)(gp + 4);
            u32x4 w; w.x = cvt_pk_bf16(v[j][0] * r * g0.x, v[j][1] * r * g0.y); w.y = cvt_pk_bf16(v[j][2] * r * g0.z, v[j][3] * r * g0.w);
            w.z = cvt_pk_bf16(v[j][4] * r * g1.x, v[j][5] * r * g1.y); w.w = cvt_pk_bf16(v[j][6] * r * g1.z, v[j][7] * r * g1.w);
            pr[64 * j] = w;
        }
    }
}

#undef a
constexpr int N_PHASES = 1 + 12 * DEPTH;

#define PH_IN(k) (lo <= (k) && (k) < hi)

#define XB_TMO      128
#define XB_XCNT(j)  (256  + 64 * (j))
#define XB_XSUB(j)  (1280 + 64 * (j))
#define XB_XGEN(j)  (2304 + 64 * (j))
#define XB_TOP      3328
#define XB_TOPGEN   3392
#define XCD_BAR_WORDS 3456
#define XB_SPIN_CAP (1u << 18)
__device__ __forceinline__ unsigned xb_ld(unsigned* p)              { return __hip_atomic_load(p, __ATOMIC_RELAXED, __HIP_MEMORY_SCOPE_AGENT); }
__device__ __forceinline__ unsigned xb_add(unsigned* p, unsigned v) { return __hip_atomic_fetch_add(p, v, __ATOMIC_RELAXED, __HIP_MEMORY_SCOPE_AGENT); }
__device__ __forceinline__ unsigned xb_xcc_id() { return (unsigned)__builtin_amdgcn_s_getreg((3 << 11) | 20) & 0xFu; }
#define XB_SPIN(cond, bar) do { unsigned _sp = 0; while (cond) { __builtin_amdgcn_s_sleep(1); \
    if ((++_sp & 255u) == 0u) { if (xb_ld(&(bar)[XB_TMO])) break; if (_sp > XB_SPIN_CAP) { atomicAdd(&(bar)[XB_TMO], 1u); break; } } } } while (0)
struct XcdBarrier { unsigned* bar; unsigned x; volatile LAS unsigned* st; };
__device__ __forceinline__ XcdBarrier xcd_barrier_post(unsigned* bar, volatile LAS unsigned* st) {
    XcdBarrier b; b.bar = bar; b.x = xb_xcc_id(); b.st = st;
    if (threadIdx.x == 0) (void)xb_add(&bar[XB_XCNT(b.x)], 1u);
    return b;
}
__device__ __forceinline__ void xcd_barrier_complete(unsigned* bar, unsigned x, unsigned& nloc, unsigned& nx) {
    const unsigned G = gridDim.x * gridDim.y * gridDim.z;
    unsigned sum, cnt, mine, sp = 0u;
    for (;;) {
        sum = 0u; cnt = 0u; mine = 0u;
#pragma unroll
        for (unsigned j = 0; j < 16; ++j) { const unsigned c = xb_ld(&bar[XB_XCNT(j)]); sum += c; cnt += (c > 0u) ? 1u : 0u; mine = (j == x) ? c : mine; }
        if (sum == G) break;
        __builtin_amdgcn_s_sleep(1);
        if ((++sp & 255u) == 0u) { if (xb_ld(&bar[XB_TMO])) break; if (sp > XB_SPIN_CAP) { atomicAdd(&bar[XB_TMO], 1u); break; } }
    }
    nloc = mine > 0u ? mine : 1u; nx = cnt > 0u ? cnt : 1u;
}
__device__ __forceinline__ void xcd_barrier(const XcdBarrier& b) {
    asm volatile("s_waitcnt vmcnt(0)" ::: "memory");
    __syncthreads();
    if (threadIdx.x == 0) {
        unsigned* bar = b.bar;
        __builtin_amdgcn_s_waitcnt(0);
        unsigned nloc = b.st[0], nx = b.st[1];
        if (nloc == 0u) { xcd_barrier_complete(bar, b.x, nloc, nx); b.st[0] = nloc; b.st[1] = nx; }
        const unsigned old = xb_add(&bar[XB_XSUB(b.x)], 1u);
        const unsigned gen = old / nloc;
        if (old + 1u == (gen + 1u) * nloc) {
            __builtin_amdgcn_fence(__ATOMIC_RELEASE, "agent");
            asm volatile("s_waitcnt vmcnt(0)" ::: "memory");
            const unsigned og = xb_add(&bar[XB_TOP], 1u);
            const unsigned tg = og / nx;
            if (og + 1u == (tg + 1u) * nx) xb_add(&bar[XB_TOPGEN], 1u);
            else XB_SPIN(xb_ld(&bar[XB_TOPGEN]) == tg, bar);
            __builtin_amdgcn_fence(__ATOMIC_ACQUIRE, "agent");
            xb_add(&bar[XB_XGEN(b.x)], 1u);
            asm volatile("s_waitcnt vmcnt(0)" ::: "memory");
        } else {
            XB_SPIN(xb_ld(&bar[XB_XGEN(b.x)]) == gen, bar);
            __builtin_amdgcn_fence(__ATOMIC_ACQUIRE, "agent");
            asm volatile("s_waitcnt vmcnt(0)" ::: "memory");
        }
    }
    __syncthreads();
}
constexpr size_t WS_BAR = 4096;
constexpr int LDS_BARST = LDS_BYTES - 64;

#ifndef PROBE_A
#define PROBE_A -1
#define PROBE_B -1
#endif
#if PROBE_A >= 0
#define PH_STAMP(k) do { if (blockIdx.x == 0 && threadIdx.x == 0) ((unsigned long long*)(ws + WS_SCAL + 1024))[k] = __builtin_amdgcn_s_memrealtime(); } while (0)
#else
#define PH_STAMP(k) do { } while (0)
#endif
#define PH_SYNC(k) do { if (coop && (k) + 1 < hi) { if (coop == 2) cg::this_grid().sync(); else xcd_barrier(xbar); } PH_STAMP((k) + 1); } while (0)
template <int L>
__device__ __forceinline__ void layer_phases(LAS unsigned char* lds, unsigned char* ws, const float* xin, float* out, int lo, int hi, int coop, const XcdBarrier xbar) {
    constexpr bool last = (L == DEPTH - 1);
    constexpr int mrows_tail = last ? ML : MT;
    constexpr int P0 = 1 + 12 * L;
    unsigned char* wl = ws + WS_W + (size_t)L * WL_STRIDE;
    const float* MOD = (const float*)(ws + WS_MOD) + (size_t)L * 3 * MODW;
    const int G = (int)gridDim.x, bid = (int)blockIdx.x;
    if (PH_IN(P0 + 0)) { if (DUP == 8 && L == 0) { phase_norm(L, 0, MT, 0, 2); xcd_barrier(xbar); } phase_norm(L, 0, MT, L == 0 ? 0 : 11, L == 0 ? 2 : 0); PH_SYNC(P0 + 0); }
    if (PH_IN(P0 + 1)) {
        pg8::Gemm g{(const bf16_t*)(ws + WS_XN), (const bf16_t*)(wl + WO_GU1), MT, 2 * FF, DM};
        pg8::StaticOrder<MT, 2 * FF, DM> S; S.init(G, bid); pg8::EpiSwiglu E{(bf16_t*)(ws + WS_H), FF};
        pg8::gemm_phase(lds, g, S, E);
        if (DUP == 1 && L == 0) { xcd_barrier(xbar); pg8::gemm_phase(lds, g, S, E); }
        PH_SYNC(P0 + 1); }
    if (PH_IN(P0 + 2)) {
        pg8::Gemm g{(const bf16_t*)(ws + WS_H), (const bf16_t*)(wl + WO_D1), MT, DM, FF};
        pg8::SplitTailOrder<ML, MT, DM, FF, 11> S; S.init(G, bid); pg8::EpiResid E{L == 0 ? xin : (const float*)(ws + WS_X), (float*)(ws + WS_X), MOD + 2 * DM, 0.5f};
        if (DUP == 2 && L == 0) { pg8::EpiResid E0 = E; E0.coef = 0.f; pg8::gemm_phase(lds, g, S, E0); xcd_barrier(xbar); }
        pg8::gemm_phase(lds, g, S, E); PH_SYNC(P0 + 2); }
    if (PH_IN(P0 + 3)) { phase_norm(L, 3, MT, 11, L == 0 ? 1 : 0); PH_SYNC(P0 + 3); }
    if (PH_IN(P0 + 4)) {
        pg8::Gemm g{(const bf16_t*)(ws + WS_XN), (const bf16_t*)(wl + WO_IN), MT, INW, DM};
        pg8::StaticOrder<MT, INW, DM> S; S.init(G, bid); pg8::EpiQKV E{(bf16_t*)(ws + WS_P), INW, (const float*)(ws + WS_SCAL + 4096) + L * 768, (LAS float*)(lds + RING_BYTES)};
        pg8::gemm_phase(lds, g, S, E); PH_SYNC(P0 + 4); }
    if (PH_IN(P0 + 6)) { if (DUP == 3 && L == 0) { phase_attn(L, !last, 32); xcd_barrier(xbar); }
        if (DUP >= 5 && DUP <= 7 && L == 0) { phase_attn(L, !last, 32, DUP == 5 ? 0 : (DUP == 6 ? 192 : 448), DUP == 5 ? 192 : (DUP == 6 ? 448 : 640)); xcd_barrier(xbar); } phase_attn(L, !last, 0); PH_SYNC(P0 + 6); }
    if (PH_IN(P0 + 7)) { phase_n3(L, mrows_tail); PH_SYNC(P0 + 7); }
    if (PH_IN(P0 + 8)) {
        pg8::Gemm g{(const bf16_t*)(ws + WS_AO), (const bf16_t*)(wl + WO_OUT), mrows_tail, DM, DM};
        pg8::SplitTailOrder<ML, mrows_tail, DM, DM, 8> S; S.init(G, bid); pg8::EpiResid E{(const float*)(ws + WS_X), (float*)(ws + WS_X), MOD + 5 * DM, 1.f};
        pg8::gemm_phase(lds, g, S, E); PH_SYNC(P0 + 8); }
    if (PH_IN(P0 + 9)) { phase_norm(L, 6, mrows_tail, 8, 0); PH_SYNC(P0 + 9); }
    if (PH_IN(P0 + 10)) {
        pg8::Gemm g{(const bf16_t*)(ws + WS_XN), (const bf16_t*)(wl + WO_GU2), mrows_tail, 2 * FF, DM};
        pg8::StaticOrder<mrows_tail, 2 * FF, DM> S; S.init(G, bid); pg8::EpiSwiglu E{(bf16_t*)(ws + WS_H), FF};
        pg8::gemm_phase(lds, g, S, E); PH_SYNC(P0 + 10); }
    if (PH_IN(P0 + 11)) {
        pg8::Gemm g{(const bf16_t*)(ws + WS_H), (const bf16_t*)(wl + WO_D2), mrows_tail, DM, FF};
        pg8::SplitTailOrder<ML, mrows_tail, DM, FF, 11> S; S.init(G, bid); pg8::EpiResid E{(const float*)(ws + WS_X), last ? out : (float*)(ws + WS_X), MOD + 8 * DM, 0.5f};
        pg8::gemm_phase(lds, g, S, E); PH_SYNC(P0 + 11); }
}

__global__ void __launch_bounds__(NTHR, 2) mega_fwd(Args args) {
    LAS unsigned char* lds = (LAS unsigned char*)lds_raw;
    unsigned char* ws = args.ws;
    const int lo = args.ph_lo, hi = args.ph_hi, coop = args.coop;
    if (threadIdx.x < 16) ((LAS unsigned*)(lds + LDS_BYTES - 64))[threadIdx.x] = 0u;
    __syncthreads();
    XcdBarrier xbar; xbar.bar = (unsigned*)(ws + WS_BAR); xbar.x = 0; xbar.st = (volatile LAS unsigned*)(lds + LDS_BARST);
    if (coop) xbar = xcd_barrier_post((unsigned*)(ws + WS_BAR), (volatile LAS unsigned*)(lds + LDS_BARST));
    PH_STAMP(0);
    if (PH_IN(0)) { phase_prologue(); PH_SYNC(0); }
    layer_phases<0>(lds, ws, args.in[I_X], args.out, lo, hi, coop, xbar);
    layer_phases<1>(lds, ws, args.in[I_X], args.out, lo, hi, coop, xbar);
#if PROBE_A >= 0
    cg::this_grid().sync(); PH_STAMP(N_PHASES);
    if (blockIdx.x == 0 && threadIdx.x == 0) { const unsigned long long* ts = (const unsigned long long*)(ws + WS_SCAL + 1024); args.out[0] += (float)(ts[PROBE_B] - ts[PROBE_A]) * 0.01f; }
#endif
}

extern "C" void kernel_launch(void* const* d_in, const int* in_sizes, int n_in, void* d_out, int out_size, void* d_ws, size_t ws_size, hipStream_t stream) {
    static int grid = 0;
    if (grid == 0) {
        if (n_in != 23 || out_size != ML * DM || ws_size < WS_END) { fprintf(stderr, "kernel_launch: unexpected shapes n_in %d out %d ws %zu\n", n_in, out_size, ws_size); grid = -1; return; }
        int dev = 0, cus = 0, per_cu = 0;
        hipGetDevice(&dev); hipDeviceGetAttribute(&cus, hipDeviceAttributeMultiprocessorCount, dev);
        hipFuncSetAttribute((const void*)mega_fwd, hipFuncAttributeMaxDynamicSharedMemorySize, LDS_BYTES);
        hipOccupancyMaxActiveBlocksPerMultiprocessor(&per_cu, (const void*)mega_fwd, NTHR, LDS_BYTES);
        if (per_cu < 1) per_cu = 1;
        grid = cus * 1;
        (void)hipGetLastError();
    }
    if (grid < 0) return;
    hipMemsetAsync((char*)d_ws + WS_CTL, 0, CTL_ZERO_BYTES, stream);
    Args a{};
    for (int i = 0; i < 23; ++i) a.in[i] = (const float*)d_in[i];
    a.out = (float*)d_out; a.ws = (unsigned char*)d_ws;
#if MK_MULTI
    for (int ph = 0; ph < N_PHASES; ++ph) { a.ph_lo = ph; a.ph_hi = ph + 1; a.coop = 0; hipLaunchKernelGGL(mega_fwd, dim3(grid), dim3(NTHR), LDS_BYTES, stream, a); }
#else
    a.ph_lo = 0; a.ph_hi = N_PHASES; a.coop = 1;
    void* kargs[] = {&a};
    hipError_t e = hipLaunchCooperativeKernel((const void*)mega_fwd, dim3(grid), dim3(NTHR), kargs, LDS_BYTES, stream);
    if (e != hipSuccess) fprintf(stderr, "cooperative launch failed: %s (grid %d)\n", hipGetErrorString(e), grid);
#endif
}
```

```cpp
#include <hip/hip_runtime.h>
#include <hip/hip_cooperative_groups.h>
#include <cstdio>
#include <cstdint>
namespace cg = cooperative_groups;

#ifndef DUP
#define DUP 0
#endif
#ifndef MK_MULTI
#define MK_MULTI 0
#endif

#define GAS __attribute__((address_space(1)))
#define LAS __attribute__((address_space(3)))
typedef unsigned short bf16_t;
typedef short bf16x8 __attribute__((ext_vector_type(8)));
typedef float f32x4 __attribute__((ext_vector_type(4)));
typedef float f32x2 __attribute__((ext_vector_type(2)));
typedef unsigned u32x4 __attribute__((ext_vector_type(4)));
typedef unsigned u32x2 __attribute__((ext_vector_type(2)));

constexpr int DM = 2048, BATCH = 2, SEQ = 4096, DEPTH = 2, GRIDW = 64, CTX = 256, NMOD = 9, FF = 5632;
constexpr int ML = BATCH * SEQ, MC = BATCH * CTX, MT = ML + MC;
constexpr int INW = 5120, MODW = NMOD * DM;
constexpr int OFF_AQ = 0, OFF_AK = 768, OFF_AV = 1024, OFF_BQ = 1280, OFF_BK = 1792, OFF_BV = 2304, OFF_CQ = 2816, OFF_CK = 3584, OFF_CV = 4352;
constexpr float RMS_EPS = 1e-6f;
constexpr int NWAVES = 8, NTHR = 512;

constexpr size_t MiB = 1u << 20;
constexpr size_t WS_CTL = 0, CTL_ZERO_BYTES = 1 * MiB;
constexpr size_t WS_MOD = 65536;
constexpr size_t WS_SCAL = 1 * MiB;
constexpr size_t WS_W = 2 * MiB, WL_STRIDE = 160 * MiB;
constexpr size_t WO_GU1 = 0, WO_D1 = 44 * MiB, WO_IN = 66 * MiB, WO_OUT = 86 * MiB, WO_GU2 = 94 * MiB, WO_D2 = 138 * MiB;
constexpr size_t WS_X = 322 * MiB;
constexpr size_t WS_XN = 390 * MiB;
constexpr size_t WS_H = 424 * MiB;
constexpr size_t WS_P = 518 * MiB;
constexpr size_t WS_AO = 604 * MiB;
constexpr size_t WS_PART = 640 * MiB;
constexpr size_t WS_END = 688 * MiB;
static_assert(WS_MOD + (size_t)DEPTH * 3 * MODW * 4 <= CTL_ZERO_BYTES, "mod inside zero region");
static_assert(WS_X + (size_t)MT * DM * 4 <= WS_XN && WS_XN + (size_t)MT * DM * 2 <= WS_H && WS_H + (size_t)MT * FF * 2 <= WS_P && WS_P + (size_t)MT * INW * 2 <= WS_AO && WS_AO + (size_t)MT * DM * 2 <= WS_END, "ws map");

constexpr int RING_BYTES = 131072, LDS_BYTES = 147456;

__device__ __forceinline__ unsigned cvt_pk_bf16(float lo, float hi) { unsigned r; asm volatile("v_cvt_pk_bf16_f32 %0, %1, %2" : "=v"(r) : "v"(lo), "v"(hi)); return r; }
__device__ __forceinline__ float bf_lo(unsigned u) { return __uint_as_float(u << 16); }
__device__ __forceinline__ float bf_hi(unsigned u) { return __uint_as_float(u & 0xffff0000u); }
template <int CTRL> __device__ __forceinline__ float dpp_f(float v) { return __uint_as_float((unsigned)__builtin_amdgcn_update_dpp(0, (int)__float_as_uint(v), CTRL, 0xf, 0xf, true)); }
template <int NL> __device__ __forceinline__ float group_sum(float v) {
    v += dpp_f<0xB1>(v);
    v += dpp_f<0x4E>(v);
    v += dpp_f<0x141>(v);
    v += dpp_f<0x140>(v);
    if (NL >= 32) v += __uint_as_float((unsigned)__builtin_amdgcn_ds_swizzle((int)__float_as_uint(v), 0x401F));
    if (NL >= 64) { auto rr = __builtin_amdgcn_permlane32_swap(__float_as_uint(v), __float_as_uint(v), false, false); v = __uint_as_float(rr[0]) + __uint_as_float(rr[1]); }
    return v;
}
__device__ __forceinline__ float wave_sum(float v) { return group_sum<64>(v); }
__device__ __forceinline__ float silu_f(float v) { return v / (1.f + __expf(-v)); }
__device__ __forceinline__ void sincos_small(float x, float& s, float& c) {
    const float k = rintf(x * 0.636619772f);
    float r = fmaf(-k, 1.57079637e+0f, x); r = fmaf(-k, -4.37113883e-8f, r);
    const float r2 = r * r;
    float sp = fmaf(r2, 2.7557319e-6f, -1.9841270e-4f); sp = fmaf(sp, r2, 8.3333333e-3f); sp = fmaf(sp, r2, -1.6666667e-1f); sp = fmaf(sp * r2, r, r);
    float cp = fmaf(r2, 2.4801587e-5f, -1.3888889e-3f); cp = fmaf(cp, r2, 4.1666667e-2f); cp = fmaf(cp, r2, -0.5f); cp = fmaf(cp, r2, 1.f);
    const int q = ((int)k) & 3;
    const float ss = (q & 1) ? cp : sp, cc = (q & 1) ? sp : cp;
    s = (q & 2) ? -ss : ss;
    c = ((q + 1) & 2) ? -cc : cc;
}

namespace pg8 {
constexpr int BM = 256, BK = 64, HALF = 128, HTB = HALF * BK * 2, STAGE_BYTES = 8 * HTB, NXCD = 8, WGM = 8;
__host__ __device__ __forceinline__ int lds_byte(int r, int c) { const int st = (r >> 4) * 2 + (c >> 5), rr = r & 15, cc = c & 31, ob = rr * 64 + cc * 2; return st * 1024 + (ob ^ (((ob >> 9) & 1) << 5)); }
__host__ __device__ __forceinline__ void stage_rc(int b, int& R, int& C) { const int st = b / 1024, sb = b % 1024, swz = sb ^ (((sb >> 9) & 1) << 5); R = (st >> 1) * 16 + swz / 64; C = (st & 1) * 32 + (swz % 64) / 2; }
__host__ __device__ __forceinline__ int perm32(int rho) { const int n = rho >> 4, i = rho & 15; return 8 * (i >> 2) + 4 * n + (i & 3); }
struct Unit { int pm, pn, k0, nt, atomic; };
struct Gemm { const bf16_t* A; const bf16_t* Bt; int M, N, K; };
template <int M, int N, int K, int WGM_ = WGM>
struct StaticOrder {
    static constexpr int nM = M / BM, nN = N / BM, nwg = nM * nN, ntk = K / BK;
    int G, c;
    __device__ __forceinline__ void init(int G_, int c_) { G = G_; c = c_; }
    __device__ __forceinline__ void map(int L, int& pm, int& pn) const {
        int wgid = L; { constexpr int q = nwg / NXCD, r = nwg % NXCD; const int xcd = wgid % NXCD, off = wgid / NXCD; wgid = (xcd < r ? xcd * (q + 1) : r * (q + 1) + (xcd - r) * q) + off; }
        constexpr int nig = WGM_ * nN; const int gid = wgid / nig, fm = gid * WGM_, gsz = (nM - fm) < WGM_ ? (nM - fm) : WGM_;
        pm = fm + ((wgid % nig) % gsz); pn = (wgid % nig) / gsz;
    }
    __device__ __forceinline__ bool next(int i, Unit& u) const {
        const int L = i * G + c; if (L >= nwg) return false;
        int pm, pn; map(L, pm, pn);
        u.pm = pm; u.pn = pn; u.k0 = 0; u.nt = ntk; u.atomic = 0; return true;
    }
};
template <int MLAT, int MTOT, int N, int K, int KS>
struct SplitTailOrder {
    StaticOrder<MLAT, N, K, 4> lat;
    static constexpr int nlat = (MLAT / BM) * (N / BM), nN = N / BM, pm0 = MLAT / BM, ntail = ((MTOT - MLAT) / BM) * nN * KS, ntk_sub = K / BK / KS;
    static_assert(KS == 1 || (K / BK) % (2 * KS) == 0, "split-K pieces need an even number of K tiles");
    __device__ __forceinline__ void init(int G_, int c_) { lat.init(G_, c_); }
    __device__ __forceinline__ bool next(int i, Unit& u) const {
        const int L = i * lat.G + lat.c;
        if (L >= nlat + ntail) return false;
        const bool tail = L >= nlat;
        int pml, pnl; lat.map(tail ? 0 : L, pml, pnl);
        const int s = tail ? L - nlat : 0, un = s / KS, ks = s % KS;
        u.pm = tail ? pm0 + un / nN : pml; u.pn = tail ? un % nN : pnl; u.nt = tail ? ntk_sub : K / BK; u.k0 = tail ? ks * ntk_sub * BK : 0; u.atomic = tail ? ks + 1 : 0;
        return true;
    }
};

struct EpiBf16 {
    static constexpr bool PERM = true;
    bf16_t* O; int ldc;
    __device__ __forceinline__ void operator()(const f32x4 (&acc)[2][2][4][2], const Unit& u, int wr, int wc, int fr, int fq) const {
        const int row0 = u.pm * BM + wr * 64 + fr, col0 = u.pn * BM + wc * 32 + 8 * fq;
#pragma unroll
        for (int ai = 0; ai < 2; ++ai)
#pragma unroll
            for (int m = 0; m < 4; ++m) { bf16_t* rowp = O + (size_t)(row0 + ai * HALF + m * 16) * ldc + col0;
#pragma unroll
                for (int bj = 0; bj < 2; ++bj) { const f32x4 v0 = acc[ai][bj][m][0], v1 = acc[ai][bj][m][1];
                    u32x4 w; w.x = cvt_pk_bf16(v0[0], v0[1]); w.y = cvt_pk_bf16(v0[2], v0[3]); w.z = cvt_pk_bf16(v1[0], v1[1]); w.w = cvt_pk_bf16(v1[2], v1[3]);
                    *(u32x4*)(rowp + bj * HALF) = w; } }
    }
};
__host__ __device__ __forceinline__ int qk_pos128(int d) { const int n = (d >> 5) & 1, q = (d & 31) + ((d >> 6) << 5); return 32 * (q >> 4) + 8 * ((q >> 2) & 3) + 4 * n + (q & 3); }
__host__ __device__ __forceinline__ int qk_pos64(int d)  { const int n = (d >> 4) & 1, q = (d & 15) + ((d >> 5) << 4); return 32 * (q >> 4) + 8 * ((q >> 2) & 3) + 4 * n + (q & 3); }
__host__ __device__ __forceinline__ int win_dest_row(int n) {
    const bool p128 = (n < 1024) || (n >= 2816 && n < 4352), p64 = (n >= 1280 && n < 2304);
    return p128 ? (n & ~127) + qk_pos128(n & 127) : (p64 ? (n & ~63) + qk_pos64(n & 63) : n);
}
struct EpiQKV {
    static constexpr bool PERM = true;
    bf16_t* O; int ldc; const float* gt; LAS float* red;
    __device__ __forceinline__ void operator()(const f32x4 (&acc)[2][2][4][2], const Unit& u, int wr, int wc, int fr_, int fq_) const {
        int fr = fr_, fq = fq_; asm volatile("" : "+v"(fr), "+v"(fq));
        const int pn = u.pn;
        const bool isv = (pn == 4) || (pn == 9) || (pn == 10) || (pn >= 17);
        if (!isv) {
            const bool hd64 = (pn >= 5 && pn <= 8);
            const bool rope = (pn <= 8) && (u.pm < 32);
            const int gidx = pn <= 2 ? 0 : (pn == 3 ? 1 : (pn <= 6 ? 2 : (pn <= 8 ? 3 : (pn <= 13 ? 4 : 5))));
            const float* gain = gt + gidx * 128;
#pragma unroll
            for (int ai = 0; ai < 2; ++ai)
#pragma unroll
                for (int m = 0; m < 4; ++m)
#pragma unroll
                    for (int bj = 0; bj < 2; ++bj) {
                        const f32x4 a0 = acc[ai][bj][m][0], a1 = acc[ai][bj][m][1];
                        float sq = (a0[0] * a0[0] + a0[1] * a0[1]) + (a0[2] * a0[2] + a0[3] * a0[3]) + (a1[0] * a1[0] + a1[1] * a1[1]) + (a1[2] * a1[2] + a1[3] * a1[3]);
                        sq += __uint_as_float((unsigned)__builtin_amdgcn_ds_swizzle((int)__float_as_uint(sq), 0x401F));
                        { auto rr = __builtin_amdgcn_permlane32_swap(__float_as_uint(sq), __float_as_uint(sq), false, false); sq = __uint_as_float(rr[0]) + __uint_as_float(rr[1]); }
                        if (fq == 0) red[((ai * HALF + wr * 64 + m * 16 + fr) * 2 + bj) * 4 + wc] = sq;
                    }
            asm volatile("s_waitcnt lgkmcnt(0)" ::: "memory"); __builtin_amdgcn_s_barrier(); asm volatile("" ::: "memory");
            const int g = hd64 ? 4 * (wc & 1) + fq : 4 * wc + fq;
            int dimb[4]; float frq[4]; bool usecol[4];
#pragma unroll
            for (int j = 0; j < 4; ++j) { const int q = 4 * g + j;
                if (hd64) { dimb[j] = q + (q >= 16 ? 16 : 0); usecol[j] = q >= 16; frq[j] = exp2f(-(float)(q & 15) * (13.287712379549449f / 16.f)); }
                else      { dimb[j] = q + (q >= 32 ? 32 : 0); usecol[j] = q >= 32; frq[j] = exp2f(-(float)(q & 31) * (13.287712379549449f / 32.f)); } }
            const int dn = hd64 ? 16 : 32;
            float g0[4], g1[4];
#pragma unroll
            for (int j = 0; j < 4; ++j) { g0[j] = gain[dimb[j]]; g1[j] = gain[dimb[j] + dn]; }
#pragma unroll
            for (int ai = 0; ai < 2; ++ai)
#pragma unroll
                for (int m = 0; m < 4; ++m) {
                    const int rl = ai * HALF + wr * 64 + m * 16 + fr, row = u.pm * BM + rl;
                    const int tt = row & (SEQ - 1); const float prow = (float)(tt >> 6), pcol = (float)(tt & 63);
                    float sn[4], cs[4];
                    if (rope) {
#pragma unroll
                        for (int j = 0; j < 4; ++j) sincos_small((usecol[j] ? pcol : prow) * frq[j], sn[j], cs[j]);
                    }
                    bf16_t* rowp = O + (size_t)row * ldc + u.pn * BM + wc * 32 + 8 * fq;
#pragma unroll
                    for (int bj = 0; bj < 2; ++bj) {
                        const f32x4 pp = *(const LAS f32x4*)(red + (rl * 2 + bj) * 4);
                        const float tot = hd64 ? ((wc & 2) ? pp[2] + pp[3] : pp[0] + pp[1]) : (pp[0] + pp[1]) + (pp[2] + pp[3]);
                        const float rstd = rsqrtf(tot * (hd64 ? 1.f / 64.f : 1.f / 128.f) + RMS_EPS);
                        float ya[4], yb[4];
#pragma unroll
                        for (int j = 0; j < 4; ++j) {
                            ya[j] = acc[ai][bj][m][0][j] * rstd * g0[j]; yb[j] = acc[ai][bj][m][1][j] * rstd * g1[j];
                            if (rope) { const float ta = ya[j] * cs[j] - yb[j] * sn[j], tb = ya[j] * sn[j] + yb[j] * cs[j]; ya[j] = ta; yb[j] = tb; }
                        }
                        u32x4 w; w.x = cvt_pk_bf16(ya[0], ya[1]); w.y = cvt_pk_bf16(ya[2], ya[3]); w.z = cvt_pk_bf16(yb[0], yb[1]); w.w = cvt_pk_bf16(yb[2], yb[3]);
                        *(u32x4*)(rowp + bj * HALF) = w;
                    }
                    __builtin_amdgcn_sched_barrier(0);
                }
            return;
        }
        const int row0 = u.pm * BM + wr * 64 + fr, col0 = u.pn * BM + wc * 32 + 8 * fq;
#pragma unroll
        for (int ai = 0; ai < 2; ++ai)
#pragma unroll
            for (int m = 0; m < 4; ++m) { bf16_t* rowp = O + (size_t)(row0 + ai * HALF + m * 16) * ldc + col0;
#pragma unroll
                for (int bj = 0; bj < 2; ++bj) { const f32x4 v0 = acc[ai][bj][m][0], v1 = acc[ai][bj][m][1];
                    u32x4 w; w.x = cvt_pk_bf16(v0[0], v0[1]); w.y = cvt_pk_bf16(v0[2], v0[3]); w.z = cvt_pk_bf16(v1[0], v1[1]); w.w = cvt_pk_bf16(v1[2], v1[3]);
                    *(u32x4*)(rowp + bj * HALF) = w; } }
    }
};
struct EpiSwiglu {
    static constexpr bool PERM = true;
    bf16_t* O; int ldc;
    __device__ __forceinline__ void operator()(const f32x4 (&acc)[2][2][4][2], const Unit& u, int wr, int wc, int fr, int fq) const {
        const int row0 = u.pm * BM + wr * 64 + fr, col0 = u.pn * HALF + wc * 32 + 8 * fq;
#pragma unroll
        for (int ai = 0; ai < 2; ++ai)
#pragma unroll
            for (int m = 0; m < 4; ++m) { bf16_t* rowp = O + (size_t)(row0 + ai * HALF + m * 16) * ldc + col0;
                float h[8];
#pragma unroll
                for (int n = 0; n < 2; ++n)
#pragma unroll
                    for (int j = 0; j < 4; ++j) { const float g = acc[ai][0][m][n][j], up = acc[ai][1][m][n][j]; h[n * 4 + j] = g * __builtin_amdgcn_rcpf(1.f + __expf(-g)) * up; }
                u32x4 w; w.x = cvt_pk_bf16(h[0], h[1]); w.y = cvt_pk_bf16(h[2], h[3]); w.z = cvt_pk_bf16(h[4], h[5]); w.w = cvt_pk_bf16(h[6], h[7]);
                *(u32x4*)rowp = w; }
    }
};
struct EpiResid {
    static constexpr bool PERM = false;
    const float* Xin; float* Xout; const float* gate; float coef;
    __device__ __forceinline__ void operator()(const f32x4 (&acc)[2][2][4][2], const Unit& u, int wr, int wc, int fr, int fq) const {
        const int grp = u.pm < 16 ? 0 : (u.pm < 32 ? 1 : 2);
        const float* gp = gate + (size_t)grp * MODW;
        const int col0 = u.pn * BM + wc * 32 + 4 * fq;
        f32x4 gv[2][2];
#pragma unroll
        for (int bj = 0; bj < 2; ++bj)
#pragma unroll
            for (int n = 0; n < 2; ++n) gv[bj][n] = *(const f32x4*)(gp + col0 + bj * HALF + n * 16) * coef;
#pragma unroll
        for (int ai = 0; ai < 2; ++ai)
#pragma unroll
            for (int m = 0; m < 4; ++m) { const size_t off = (size_t)(u.pm * BM + ai * HALF + wr * 64 + m * 16 + fr) * DM + col0;
#pragma unroll
                for (int bj = 0; bj < 2; ++bj)
#pragma unroll
                    for (int n = 0; n < 2; ++n) {
                        if (u.atomic) { float* part = (float*)((char*)Xout + (WS_PART - WS_X)); *(f32x4*)(part + (size_t)(u.atomic - 1) * MC * DM + (off - (size_t)ML * DM) + bj * HALF + n * 16) = gv[bj][n] * acc[ai][bj][m][n]; }
                        else { const f32x4 xi = *(const f32x4*)(Xin + off + bj * HALF + n * 16);
                            *(f32x4*)(Xout + off + bj * HALF + n * 16) = xi + gv[bj][n] * acc[ai][bj][m][n]; } } }
    }
};

template <class Epi, class Sched>
__device__ __forceinline__ void gemm_phase(LAS unsigned char* lds, const Gemm g, const Sched& S, const Epi& E) {
    const int tid = threadIdx.x, wid = __builtin_amdgcn_readfirstlane(tid >> 6), lane = tid & 63, wr = wid >> 2, wc = wid & 3, fr = lane & 15, fq = lane >> 4;
    const int K = g.K;
    unsigned voffA[2], voffB[2];
#pragma unroll
    for (int i = 0; i < 2; ++i) { int R, C; stage_rc(tid * 16 + i * 8192, R, C); const int Rb = Epi::PERM ? ((R & ~31) + perm32(R & 31)) : R;
        voffA[i] = (unsigned)(R * K + C) * 2u; voffB[i] = (unsigned)(Rb * K + C) * 2u; }
    const size_t kstep = (size_t)(BK * 2);
    const size_t hstep = (size_t)HALF * K * 2;
    const size_t tstep = 2 * hstep;
    const unsigned ldsw = (unsigned)wid * 1024u;
    const int aoff = lds_byte(wr * 64 + fr, fq * 8), boff = lds_byte(wc * 32 + fr, fq * 8);
#define PG8_SA(b, h) (((b) * 2 + (h)) * HTB)
#define PG8_SB(b, h) ((4 + (b) * 2 + (h)) * HTB)
#define PG8_STAGE(bufoff, gbase, voff) do { _Pragma("unroll") for (int _i = 0; _i < 2; ++_i) \
        __builtin_amdgcn_global_load_lds((const unsigned*)((const char*)(gbase) + (voff)[_i]), (LAS unsigned*)(lds + (bufoff) + ldsw + _i * 8192), 16, 0, 0); } while (0)
#define PG8_LDA(dst, b, h) do { _Pragma("unroll") for (int m = 0; m < 4; ++m) _Pragma("unroll") for (int k = 0; k < 2; ++k) dst[m][k] = *(const LAS bf16x8*)(lds + PG8_SA(b, h) + aoff + m * 2048 + k * 1024); } while (0)
#define PG8_LDB(dst, b, h) do { _Pragma("unroll") for (int n = 0; n < 2; ++n) _Pragma("unroll") for (int k = 0; k < 2; ++k) dst[n][k] = *(const LAS bf16x8*)(lds + PG8_SB(b, h) + boff + n * 2048 + k * 1024); } while (0)
#define PG8_MMA(ai, bj, At, Bt) do { __builtin_amdgcn_s_setprio(1); _Pragma("unroll") for (int m = 0; m < 4; ++m) _Pragma("unroll") for (int n = 0; n < 2; ++n) _Pragma("unroll") for (int k = 0; k < 2; ++k) \
        acc[ai][bj][m][n] = __builtin_amdgcn_mfma_f32_16x16x32_bf16(Bt[n][k], At[m][k], acc[ai][bj][m][n], 0, 0, 0); __builtin_amdgcn_s_setprio(0); } while (0)
#define PG8_WAIT_V(n) asm volatile("s_waitcnt vmcnt(" #n ")" ::: "memory")
#define PG8_WAIT_L(n) asm volatile("s_waitcnt lgkmcnt(" #n ")" ::: "memory")
#define PG8_BAR __builtin_amdgcn_s_barrier()
#define PG8_SCHED __builtin_amdgcn_sched_barrier(0)
    Unit cur, nxt; int ui = 0;
    if (!S.next(0, cur)) return;
    f32x4 acc[2][2][4][2];
#pragma unroll
    for (int a = 0; a < 2; ++a)
#pragma unroll
        for (int b = 0; b < 2; ++b)
#pragma unroll
            for (int m = 0; m < 4; ++m)
#pragma unroll
                for (int n = 0; n < 2; ++n) acc[a][b][m][n] = (f32x4){0.f, 0.f, 0.f, 0.f};
    bf16x8 At[4][2], B0[2][2], B1[2][2];
    const char* cA = (const char*)g.A + (size_t)cur.pm * tstep + (size_t)cur.k0 * 2; const char* cB = (const char*)g.Bt + (size_t)cur.pn * tstep + (size_t)cur.k0 * 2;
    PG8_STAGE(PG8_SB(0, 0), cB, voffB); PG8_STAGE(PG8_SB(0, 1), cB + hstep, voffB); PG8_STAGE(PG8_SA(0, 0), cA, voffA); PG8_STAGE(PG8_SA(0, 1), cA + hstep, voffA);
    if (wr == 1) PG8_BAR;
    PG8_WAIT_V(2); PG8_BAR;
    PG8_STAGE(PG8_SB(1, 0), cB + kstep, voffB); PG8_STAGE(PG8_SA(1, 0), cA + kstep, voffA); PG8_STAGE(PG8_SB(1, 1), cB + hstep + kstep, voffB);
    PG8_WAIT_V(6); PG8_BAR;
    for (;;) {
        const bool has_next = S.next(ui + 1, nxt);
        const char* nA = has_next ? (const char*)g.A + (size_t)nxt.pm * tstep + (size_t)nxt.k0 * 2 : cA; const char* nB = has_next ? (const char*)g.Bt + (size_t)nxt.pn * tstep + (size_t)nxt.k0 * 2 : cB;
        const int nt = cur.nt;
        for (int t = 0; t < nt; t += 2) {
            const bool last = (t == nt - 2);
            const char* a1 = cA + (size_t)(t + 1) * kstep;
            const char* a2 = last ? nA : cA + (size_t)(t + 2) * kstep; const char* b2 = last ? nB : cB + (size_t)(t + 2) * kstep;
            const char* a3 = a2 + kstep; const char* b3 = b2 + kstep;
            PG8_LDB(B0, 0, 0); PG8_LDB(B1, 0, 1); PG8_SCHED; PG8_LDA(At, 0, 0); PG8_STAGE(PG8_SA(1, 1), a1 + hstep, voffA);
            PG8_WAIT_V(8); PG8_WAIT_L(0); PG8_BAR; PG8_MMA(0, 0, At, B0); PG8_MMA(0, 1, At, B1); PG8_BAR; PG8_SCHED;
            PG8_LDA(At, 0, 1); PG8_STAGE(PG8_SB(0, 0), b2, voffB); PG8_STAGE(PG8_SB(0, 1), b2 + hstep, voffB); PG8_STAGE(PG8_SA(0, 0), a2, voffA);
            PG8_WAIT_V(8); PG8_WAIT_L(0); PG8_BAR; PG8_MMA(1, 0, At, B0); PG8_MMA(1, 1, At, B1); PG8_BAR; PG8_SCHED;
            PG8_LDB(B0, 1, 0); PG8_LDB(B1, 1, 1); PG8_SCHED; PG8_LDA(At, 1, 0); PG8_STAGE(PG8_SA(0, 1), a2 + hstep, voffA);
            PG8_WAIT_V(8); PG8_WAIT_L(0); PG8_BAR; PG8_MMA(0, 0, At, B0); PG8_MMA(0, 1, At, B1); PG8_BAR; PG8_SCHED;
            PG8_LDA(At, 1, 1); PG8_STAGE(PG8_SB(1, 0), b3, voffB); PG8_STAGE(PG8_SB(1, 1), b3 + hstep, voffB); PG8_STAGE(PG8_SA(1, 0), a3, voffA);
            PG8_WAIT_V(8); PG8_WAIT_L(0); PG8_BAR; PG8_MMA(1, 0, At, B0); PG8_MMA(1, 1, At, B1); PG8_BAR; PG8_SCHED;
        }
        if (wr == 0) PG8_BAR;
        E(acc, cur, wr, wc, fr, fq);
        if (!has_next) break;
#pragma unroll
        for (int a = 0; a < 2; ++a)
#pragma unroll
            for (int b = 0; b < 2; ++b)
#pragma unroll
                for (int m = 0; m < 4; ++m)
#pragma unroll
                    for (int n = 0; n < 2; ++n) acc[a][b][m][n] = (f32x4){0.f, 0.f, 0.f, 0.f};
        cur = nxt; cA = nA; cB = nB; ++ui;
        if (wr == 1) PG8_BAR;
    }
    PG8_WAIT_V(0);
    PG8_BAR;
#undef PG8_SA
#undef PG8_SB
#undef PG8_STAGE
#undef PG8_LDA
#undef PG8_LDB
#undef PG8_MMA
#undef PG8_WAIT_V
#undef PG8_WAIT_L
#undef PG8_BAR
#undef PG8_SCHED
}
}

struct Args { const float* in[23]; float* out; unsigned char* ws; int ph_lo, ph_hi, coop, pad; };
enum { I_X = 0, I_C, I_CTX, I_CCTX, I_WMOD, I_BMOD, I_F1GU, I_F1D, I_F2GU, I_F2D, I_WIN, I_WOUT, I_AQG, I_AKG, I_AOG, I_BQG, I_BKG, I_BLAM, I_BOG, I_CQG, I_CKG, I_CRB, I_COG };

typedef const __attribute__((address_space(4))) Args* KArgs;
__device__ __forceinline__ KArgs get_args() { KArgs p = (KArgs)__builtin_amdgcn_kernarg_segment_ptr(); asm volatile("" : "+s"(p)); return p; }

struct Ctx {
    LAS unsigned char* lds; int tid, lane, wave, G, gw, NGW;
    unsigned char* ws;
};
extern __shared__ __attribute__((aligned(16))) unsigned char lds_raw[];
__device__ __forceinline__ Ctx make_ctx(KArgs ap) {
    Ctx F; int tid = threadIdx.x, bid = blockIdx.x, G = gridDim.x;
    asm volatile("" : "+v"(tid)); asm volatile("" : "+s"(bid)); asm volatile("" : "+s"(G));
    F.lds = (LAS unsigned char*)lds_raw; F.tid = tid; F.lane = tid & 63; F.wave = __builtin_amdgcn_readfirstlane(tid >> 6);
    F.G = G; F.gw = bid * NWAVES + F.wave; F.NGW = G * NWAVES; F.ws = ap->ws;
    return F;
}

__device__ __forceinline__ void transpose_item(const float* W, int K, int N, bf16_t* WT, int k0, int n0, int drow0, LAS float* scr, int lane) {
#pragma unroll 8
    for (int i = 0; i < 32; ++i) { const int kk = 2 * i + (lane >> 5); scr[kk * 33 + (lane & 31)] = W[(size_t)(k0 + kk) * N + n0 + (lane & 31)]; }
    asm volatile("s_waitcnt lgkmcnt(0)" ::: "memory");
    const int c = lane & 7;
#pragma unroll
    for (int j = 0; j < 4; ++j) { const int n = (lane >> 3) + 8 * j; const LAS float* s = scr + (8 * c) * 33 + n;
        u32x4 o; o.x = cvt_pk_bf16(s[0 * 33], s[1 * 33]); o.y = cvt_pk_bf16(s[2 * 33], s[3 * 33]); o.z = cvt_pk_bf16(s[4 * 33], s[5 * 33]); o.w = cvt_pk_bf16(s[6 * 33], s[7 * 33]);
        *(u32x4*)(WT + (size_t)(drow0 + n) * K + k0 + 8 * c) = o; }
    asm volatile("s_waitcnt lgkmcnt(0)" ::: "memory");
}

__device__ __forceinline__ void transpose_item64(const float* W, int K, int N, bf16_t* WT, int k0, int n0, int drow0, LAS float* scr, int lane, bool win = false) {
    const int lr = lane >> 4, lc = (lane & 15) * 4;
    f32x4 v[16];
#pragma unroll
    for (int i = 0; i < 16; ++i) v[i] = *(const f32x4*)(W + (size_t)(k0 + 4 * i + lr) * N + n0 + lc);
#pragma unroll
    for (int i = 0; i < 16; ++i) { LAS float* d = scr + (4 * i + lr) * 65 + lc; d[0] = v[i].x; d[1] = v[i].y; d[2] = v[i].z; d[3] = v[i].w; }
    asm volatile("s_waitcnt lgkmcnt(0)" ::: "memory");
    const int c = lane & 7;
#pragma unroll
    for (int j = 0; j < 8; ++j) { const int n = (lane >> 3) + 8 * j; const LAS float* sp = scr + (8 * c) * 65 + n;
        u32x4 o; o.x = cvt_pk_bf16(sp[0 * 65], sp[1 * 65]); o.y = cvt_pk_bf16(sp[2 * 65], sp[3 * 65]); o.z = cvt_pk_bf16(sp[4 * 65], sp[5 * 65]); o.w = cvt_pk_bf16(sp[6 * 65], sp[7 * 65]);
        const int drow = win ? pg8::win_dest_row(n0 + n) : drow0 + n;
        *(u32x4*)(WT + (size_t)drow * K + k0 + 8 * c) = o; }
    asm volatile("s_waitcnt lgkmcnt(0)" ::: "memory");
}

__device__ __forceinline__ void phase_prologue() {
    const KArgs ap = get_args(); Ctx F = make_ctx(ap);
#define a (*ap)
    LAS float* sil = (LAS float*)(F.lds + 73728);
    for (int i = F.tid; i < 3 * DM; i += NTHR) {
        const int g = i / DM, k = i % DM;
        const float v = (g == 0) ? a.in[I_C][k] : (g == 1) ? a.in[I_C][DM + k] : a.in[I_CCTX][k];
        sil[i] = silu_f(v);
    }
    __syncthreads();
    if (F.gw / NWAVES == 1) {
        float* GT = (float*)(F.ws + WS_SCAL + 4096);
        for (int i = F.tid; i < DEPTH * 6 * 128; i += NTHR) { const int l = i / 768, r = i % 768, t = r / 128, d = r % 128;
            const int src = (t == 0) ? I_AQG : (t == 1) ? I_AKG : (t == 2) ? I_BQG : (t == 3) ? I_BKG : (t == 4) ? I_CQG : I_CKG;
            const bool b64 = (t == 2 || t == 3);
            GT[i] = b64 ? (d < 64 ? a.in[src][l * 64 + d] : 0.f) : a.in[src][l * 128 + d]; }
    }
    if (F.gw == 0) {
        for (int l = 0; l < DEPTH; ++l) {
            const float* lv = a.in[I_BLAM] + l * 256;
            const float s1 = wave_sum(lv[F.lane] * lv[64 + F.lane]), s2 = wave_sum(lv[128 + F.lane] * lv[192 + F.lane]);
            const float lam_init = (l == 0) ? 0.2f : 0.35550906f;
            if (F.lane == 0) ((float*)(F.ws + WS_SCAL))[l] = expf(s1) - expf(s2) + lam_init;
        }
    }
    {
        float* MOD = (float*)(F.ws + WS_MOD);
        LAS f32x4* red = (LAS f32x4*)(F.lds + 98304);
        constexpr int NCC = MODW / 256;
        for (int it = F.gw / NWAVES; it < DEPTH * NCC; it += F.G) {
            const int l = it / NCC, cc = it % NCC, col = cc * 256 + F.lane * 4;
            const float* W = a.in[I_WMOD] + (size_t)l * DM * MODW + col;
            f32x4 a0 = {0, 0, 0, 0}, a1 = a0, a2 = a0;
#pragma unroll 16
            for (int k = F.wave * 256; k < (F.wave + 1) * 256; ++k) {
                const f32x4 w = *(const f32x4*)(W + (size_t)k * MODW);
                const float s0 = sil[k], s1 = sil[DM + k], s2 = sil[2 * DM + k];
                a0 += w * s0; a1 += w * s1; a2 += w * s2;
            }
            red[(F.wave * 3 + 0) * 64 + F.lane] = a0; red[(F.wave * 3 + 1) * 64 + F.lane] = a1; red[(F.wave * 3 + 2) * 64 + F.lane] = a2;
            __syncthreads();
            if (F.wave < 3) {
                f32x4 t = *(const f32x4*)(a.in[I_BMOD] + (size_t)l * MODW + col);
#pragma unroll
                for (int w = 0; w < 8; ++w) t += red[(w * 3 + F.wave) * 64 + F.lane];
                *(f32x4*)(MOD + ((size_t)l * 3 + F.wave) * MODW + col) = t;
            }
            __syncthreads();
        }
    }
    __syncthreads();
    {
        constexpr int IT_GU = (DM / 64) * (2 * FF / 64), IT_D = (FF / 64) * (DM / 64), IT_IN = (DM / 64) * (INW / 64), IT_OUT = (DM / 64) * (DM / 64);
        constexpr int IT_L = 2 * IT_GU + 2 * IT_D + IT_IN + IT_OUT, IT_ALL = DEPTH * IT_L;
        LAS float* scr = (LAS float*)(F.lds + F.wave * 16640);
        int it_lo, it_hi, it_step;
        if (F.G == 256) {
            static_assert(IT_ALL == 1152 * 16 + 22528, "transpose item split");
            const int bid = F.gw / NWAVES;
            if (bid < 144) { it_lo = F.gw * 16; it_hi = it_lo + 16; }
            else { const int v = F.gw - 1152; it_lo = 18432 + (v * 176) / 7; it_hi = 18432 + ((v + 1) * 176) / 7; }
            it_step = 1;
        } else { it_lo = F.gw; it_hi = IT_ALL; it_step = F.NGW; }
        for (int rep_ = 0; rep_ < (DUP == 4 ? 2 : 1); ++rep_)
        for (int it = it_lo; it < it_hi; it += it_step) {
            const int l = it / IT_L; int r = it % IT_L;
            unsigned char* wl = F.ws + WS_W + (size_t)l * WL_STRIDE;
            const float* W; int K, N; bf16_t* WT; bool gu = false, win = false;
            if (r < IT_GU) { W = a.in[I_F1GU] + (size_t)l * DM * 2 * FF; K = DM; N = 2 * FF; WT = (bf16_t*)(wl + WO_GU1); gu = true; }
            else if ((r -= IT_GU) < IT_GU) { W = a.in[I_F2GU] + (size_t)l * DM * 2 * FF; K = DM; N = 2 * FF; WT = (bf16_t*)(wl + WO_GU2); gu = true; }
            else if ((r -= IT_GU) < IT_D) { W = a.in[I_F1D] + (size_t)l * FF * DM; K = FF; N = DM; WT = (bf16_t*)(wl + WO_D1); }
            else if ((r -= IT_D) < IT_D) { W = a.in[I_F2D] + (size_t)l * FF * DM; K = FF; N = DM; WT = (bf16_t*)(wl + WO_D2); }
            else if ((r -= IT_D) < IT_IN) { W = a.in[I_WIN] + (size_t)l * DM * INW; K = DM; N = INW; WT = (bf16_t*)(wl + WO_IN); win = true; }
            else { r -= IT_IN; W = a.in[I_WOUT] + (size_t)l * DM * DM; K = DM; N = DM; WT = (bf16_t*)(wl + WO_OUT); }
            const int nblk = N / 64, kb = r / nblk, nb = r % nblk, n0 = 64 * nb;
            int drow0 = n0;
            if (gu) { const int j = (n0 < FF) ? n0 : n0 - FF; drow0 = (j >> 7) * 256 + ((n0 < FF) ? 0 : 128) + (j & 127); }
            transpose_item64(W, K, N, WT, 64 * kb, n0, drow0, scr, F.lane, win);
        }
    }
}

#undef a
__device__ __forceinline__ void phase_norm(int l, int ishift, int nrows, int npart, int srcmode) {
    const KArgs ap = get_args(); Ctx F = make_ctx(ap);
    const float* lat_src = srcmode == 2 ? ap->in[I_X] : (const float*)(F.ws + WS_X);
    const float* ctx_src = srcmode >= 1 ? ap->in[I_CTX] : (const float*)(F.ws + WS_X) + (size_t)ML * DM;
    const float* MOD = (const float*)(F.ws + WS_MOD) + (size_t)l * 3 * MODW;
    const float* X = (const float*)(F.ws + WS_X); bf16_t* XN = (bf16_t*)(F.ws + WS_XN);
    LAS f32x4* msc = (LAS f32x4*)F.lds;
    for (int i = F.tid; i < 3 * 2 * (DM / 4); i += NTHR) { const int g = i / (2 * (DM / 4)), r = i % (2 * (DM / 4)), w = r / (DM / 4), c = r % (DM / 4);
        const f32x4 t = *((const f32x4*)(MOD + (size_t)g * MODW + (ishift + (w ? 0 : 1)) * DM) + c); msc[i] = w ? t : t + 1.f; }
    __syncthreads();
    for (int row0 = (F.gw / NWAVES) + F.G * F.wave; row0 < nrows; row0 += 2 * F.NGW) {
        const int row1 = row0 + F.NGW; const bool has1 = row1 < nrows;
        const int row1c = has1 ? row1 : row0;
        const f32x4* xr0 = (const f32x4*)(row0 < ML ? lat_src + (size_t)row0 * DM : ctx_src + (size_t)(row0 - ML) * DM) + F.lane;
        const f32x4* xr1 = (const f32x4*)(row1c < ML ? lat_src + (size_t)row1c * DM : ctx_src + (size_t)(row1c - ML) * DM) + F.lane;
        f32x4 v0[8], v1[8];
#pragma unroll
        for (int j = 0; j < 8; ++j) v0[j] = xr0[64 * j];
#pragma unroll
        for (int j = 0; j < 8; ++j) v1[j] = xr1[64 * j];
#pragma unroll
        for (int rsel = 0; rsel < 2; ++rsel) {
            const int row = rsel ? row1 : row0; if (rsel && !has1) break;
            f32x4 (&v)[8] = rsel ? v1 : v0;
            const int grp = row < SEQ ? 0 : (row < ML ? 1 : 2);
            float s = 0.f;
            if (row >= ML && npart > 0) {
                const f32x4* pr = (const f32x4*)(F.ws + WS_PART) + (size_t)(row - ML) * (DM / 4) + F.lane;
#pragma unroll 1
                for (int p = 0; p < npart; ++p) {
#pragma unroll
                    for (int j = 0; j < 8; ++j) v[j] += pr[(size_t)p * MC * (DM / 4) + 64 * j]; }
                f32x4* xw = (f32x4*)(F.ws + WS_X + (size_t)row * DM * 4) + F.lane;
#pragma unroll
                for (int j = 0; j < 8; ++j) xw[64 * j] = v[j];
            }
#pragma unroll
            for (int j = 0; j < 8; ++j) s += (v[j].x * v[j].x + v[j].y * v[j].y) + (v[j].z * v[j].z + v[j].w * v[j].w);
            const float rstd = rsqrtf(wave_sum(s) * (1.f / DM) + RMS_EPS);
            const LAS f32x4* sc = msc + (grp * 2 + 0) * (DM / 4) + F.lane; const LAS f32x4* sh = msc + (grp * 2 + 1) * (DM / 4) + F.lane;
            u32x2* o = (u32x2*)(XN + (size_t)row * DM) + F.lane;
#pragma unroll
            for (int j = 0; j < 8; ++j) { const f32x4 y = v[j] * rstd * sc[64 * j] + sh[64 * j]; u32x2 w; w.x = cvt_pk_bf16(y.x, y.y); w.y = cvt_pk_bf16(y.z, y.w); o[64 * j] = w; }
        }
    }
}

template <int HDIM> struct QkMap {
    static constexpr int LPH = HDIM / 4, LPHALF = HDIM / 8;
    int hs, half, ip, a0, b0;
    __device__ __forceinline__ QkMap(int lane) { hs = lane / LPH; const int u = lane % LPH; half = u / LPHALF; ip = u % LPHALF; a0 = half * (HDIM / 2) + 2 * ip; b0 = a0 + HDIM / 4; }
};
template <int HDIM>
__device__ __forceinline__ void qk_compute(unsigned& ua, unsigned& ub, const QkMap<HDIM>& m, const float* gain, bool rope, int prow_pos, int pcol_pos) {
    float xa0 = bf_lo(ua), xa1 = bf_hi(ua), xb0 = bf_lo(ub), xb1 = bf_hi(ub);
    float ss = xa0 * xa0 + xa1 * xa1 + xb0 * xb0 + xb1 * xb1;
    ss = group_sum<QkMap<HDIM>::LPH>(ss);
    const float rstd = rsqrtf(ss * (1.f / HDIM) + RMS_EPS);
    xa0 *= rstd * gain[m.a0]; xa1 *= rstd * gain[m.a0 + 1]; xb0 *= rstd * gain[m.b0]; xb1 *= rstd * gain[m.b0 + 1];
    if (rope) {
        const float pos = (float)(m.half ? pcol_pos : prow_pos);
        constexpr float L2T = 13.287712379549449f;
        const float f0 = exp2f(-(float)(2 * m.ip) * (L2T / (HDIM / 4))), f1 = exp2f(-(float)(2 * m.ip + 1) * (L2T / (HDIM / 4)));
        float s0, c0, s1, c1; sincos_small(pos * f0, s0, c0); sincos_small(pos * f1, s1, c1);
        const float ya0 = xa0 * c0 - xb0 * s0, yb0 = xa0 * s0 + xb0 * c0, ya1 = xa1 * c1 - xb1 * s1, yb1 = xa1 * s1 + xb1 * c1;
        xa0 = ya0; xb0 = yb0; xa1 = ya1; xb1 = yb1;
    }
    ua = cvt_pk_bf16(xa0, xa1); ub = cvt_pk_bf16(xb0, xb1);
}
__device__ __forceinline__ void phase_qk(int l) {
    const KArgs ap = get_args(); Ctx F = make_ctx(ap);
#define a (*ap)
    bf16_t* P = (bf16_t*)(F.ws + WS_P);
    const float* aqg = a.in[I_AQG] + l * 128; const float* akg = a.in[I_AKG] + l * 128;
    const float* bqg = a.in[I_BQG] + l * 64;  const float* bkg = a.in[I_BKG] + l * 64;
    const float* cqg = a.in[I_CQG] + l * 128; const float* ckg = a.in[I_CKG] + l * 128;
    const QkMap<128> m1(F.lane); const QkMap<64> m2(F.lane);
    constexpr int NS = 14;
    constexpr int scol[NS] = {OFF_AQ, OFF_AQ + 256, OFF_AQ + 512, OFF_AK, OFF_BQ, OFF_BQ + 256, OFF_BK, OFF_BK + 256, OFF_CQ, OFF_CQ + 256, OFF_CQ + 512, OFF_CK, OFF_CK + 256, OFF_CK + 512};
    for (int row = (F.gw / NWAVES) + F.G * F.wave; row < MT; row += F.NGW) {
        bf16_t* pr = P + (size_t)row * INW;
        const bool lat = row < ML; const int t = row & (SEQ - 1), rr = t >> 6, cc = t & 63;
        unsigned ua[NS], ub[NS];
#pragma unroll
        for (int s = 0; s < NS; ++s) { const bool isb = (s >= 4 && s < 8);
            const int oa = scol[s] + (isb ? m2.hs * 64 + m2.a0 : m1.hs * 128 + m1.a0), ob = scol[s] + (isb ? m2.hs * 64 + m2.b0 : m1.hs * 128 + m1.b0);
            ua[s] = *(const unsigned*)(pr + oa); ub[s] = *(const unsigned*)(pr + ob); }
#pragma unroll
        for (int s = 0; s < NS; ++s) {
            if (s < 3) qk_compute<128>(ua[s], ub[s], m1, aqg, lat, rr, cc);
            else if (s == 3) qk_compute<128>(ua[s], ub[s], m1, akg, lat, rr, cc);
            else if (s < 6) qk_compute<64>(ua[s], ub[s], m2, bqg, lat, rr, cc);
            else if (s < 8) qk_compute<64>(ua[s], ub[s], m2, bkg, lat, rr, cc);
            else if (s < 11) qk_compute<128>(ua[s], ub[s], m1, cqg, false, rr, cc);
            else qk_compute<128>(ua[s], ub[s], m1, ckg, false, rr, cc);
        }
#pragma unroll
        for (int s = 0; s < NS; ++s) { const bool isb = (s >= 4 && s < 8);
            const int oa = scol[s] + (isb ? m2.hs * 64 + m2.a0 : m1.hs * 128 + m1.a0), ob = scol[s] + (isb ? m2.hs * 64 + m2.b0 : m1.hs * 128 + m1.b0);
            *(unsigned*)(pr + oa) = ua[s]; *(unsigned*)(pr + ob) = ub[s]; }
    }
}

#undef a
struct NaiveAcc { float m, l, o0, o1; };
__device__ __forceinline__ void naive_key(NaiveAcc& A, const bf16_t* P, int krow, int kcol, int vcol, float q0, float q1, float scale, float bias, int lane) {
    const unsigned kk = *(const unsigned*)(P + (size_t)krow * INW + kcol + 2 * lane);
    const float s = wave_sum(q0 * bf_lo(kk) + q1 * bf_hi(kk)) * scale + bias;
    const float mn = fmaxf(A.m, s), al = __expf(A.m - mn), p = __expf(s - mn);
    const unsigned vv = *(const unsigned*)(P + (size_t)krow * INW + vcol + 2 * lane);
    A.l = A.l * al + p; A.o0 = A.o0 * al + p * bf_lo(vv); A.o1 = A.o1 * al + p * bf_hi(vv); A.m = mn;
}
__device__ __forceinline__ void phase_attn_naive(int l, bool with_ctx) {
    const KArgs ap = get_args(); Ctx F = make_ctx(ap);
#define a (*ap)
    const bf16_t* P = (const bf16_t*)(F.ws + WS_P); bf16_t* AO = (bf16_t*)(F.ws + WS_AO);
    const float lam = ((const float*)(F.ws + WS_SCAL))[l];
    const int nrows = with_ctx ? MT : ML;
    const int nitems = nrows * 16;
    for (int it = F.gw; it < nitems; it += F.NGW) {
        int row, hd;
        if (it < ML * 16) { const int b = it / (SEQ * 16), r = it % (SEQ * 16); hd = r / SEQ; row = b * SEQ + r % SEQ; }
        else { const int r0 = it - ML * 16; const int b = r0 / (CTX * 16), r = r0 % (CTX * 16); hd = r / CTX; row = ML + b * CTX + r % CTX; }
        const bool lat = row < ML; const int b = lat ? row / SEQ : (row - ML) / CTX;
        const int t = row & (SEQ - 1), qr = t >> 6, qc = t & 63;
        const int ctx0 = ML + b * CTX, lat0 = b * SEQ;
        float o0, o1;
        if (hd < 6 || hd >= 10) {
            const bool isC = hd >= 10; const int h = isC ? hd - 10 : hd;
            const int qcol = isC ? OFF_CQ + h * 128 : OFF_AQ + h * 128;
            const int kcol = isC ? OFF_CK + h * 128 : OFF_AK + (h / 3) * 128;
            const int vcol = isC ? OFF_CV + h * 128 : OFF_AV + (h / 3) * 128;
            const unsigned qq = *(const unsigned*)(P + (size_t)row * INW + qcol + 2 * F.lane);
            const float q0 = bf_lo(qq), q1 = bf_hi(qq); const float scale = 0.08838834764831845f;
            NaiveAcc A{-1e30f, 0.f, 0.f, 0.f};
            for (int i = 0; i < CTX; ++i) naive_key(A, P, ctx0 + i, kcol, vcol, q0, q1, scale, 0.f, F.lane);
            if (lat) {
                if (!isC) { for (int i = 0; i < SEQ; ++i) naive_key(A, P, lat0 + i, kcol, vcol, q0, q1, scale, 0.f, F.lane); }
                else {
                    const int rs = min(max(qr - 4, 0), 56), cs = min(max(qc - 8, 0), 48);
                    const float* rb = a.in[I_CRB] + ((size_t)l * 6 + h) * 15 * 31;
                    for (int w = 0; w < 128; ++w) { const int kr = rs + (w >> 4), kc = cs + (w & 15);
                        naive_key(A, P, lat0 + kr * 64 + kc, kcol, vcol, q0, q1, scale, rb[(kr - qr + 7) * 31 + (kc - qc + 15)], F.lane); }
                }
            }
            const float il = 1.f / A.l; o0 = A.o0 * il; o1 = A.o1 * il;
        } else {
            const int h = hd - 6; const int vcol = OFF_BV + h * 128; const float scale = 0.125f;
            float r0[2], r1[2];
#pragma unroll 1
            for (int sub = 0; sub < 2; ++sub) {
                const int qcol = OFF_BQ + h * 128 + sub * 64, kcol = OFF_BK + h * 128 + sub * 64;
                const unsigned qq = *(const unsigned*)(P + (size_t)row * INW + qcol + 2 * F.lane);
                const float q0 = F.lane < 32 ? bf_lo(qq) : 0.f, q1 = F.lane < 32 ? bf_hi(qq) : 0.f;
                NaiveAcc A{-1e30f, 0.f, 0.f, 0.f};
                for (int i = 0; i < CTX; ++i) naive_key(A, P, ctx0 + i, kcol, vcol, q0, q1, scale, 0.f, F.lane);
                if (lat) for (int i = 0; i < SEQ; ++i) naive_key(A, P, lat0 + i, kcol, vcol, q0, q1, scale, 0.f, F.lane);
                const float il = 1.f / A.l; r0[sub] = A.o0 * il; r1[sub] = A.o1 * il;
            }
            o0 = r0[0] - lam * r0[1]; o1 = r1[0] - lam * r1[1];
        }
        *(unsigned*)(AO + (size_t)row * DM + hd * 128 + 2 * F.lane) = cvt_pk_bf16(o0, o1);
    }
}

#undef a
namespace fa {
using f32x16 = __attribute__((ext_vector_type(16))) float;
using s16x4 = __attribute__((ext_vector_type(4))) short;
constexpr int D = 128, NW = 8, QBLK = 32, KVBLK = 64, LDK = INW;
constexpr int SHM_V = KVBLK * D * 2, SHM_K = KVBLK * D * 2;
constexpr int NSLOT = 3;
constexpr int OFF_WS = NSLOT * SHM_V + NSLOT * SHM_K, OFF_BIAS = OFF_WS + NW * 64 * 4, OFF_UNIT = OFF_BIAS + 2048;
constexpr float THR = 8.f, NEG = -1e30f;
#define KSWZ(row, colB) ((row) * 256 + ((colB) ^ (((row) & 7) << 4)))
#define SBAR() __builtin_amdgcn_sched_barrier(0)
__device__ __forceinline__ int crow(int r, int hi) { return (r & 3) + 8 * (r >> 2) + 4 * hi; }

template <int MODE> struct Sc { static constexpr float SCALE = (MODE == 1) ? 0.125f : 0.088388347648318440f; };

template <int MODE>
__device__ __forceinline__ void partialSM(f32x16& p0, f32x16& p1, float& m_reg, float& mn, float& alpha) {
  constexpr float SCALE = Sc<MODE>::SCALE, C = SCALE * 1.4426950408889634f;
  float pmax = p0[0];
#pragma unroll
  for (int r = 1; r < 16; ++r) pmax = fmaxf(pmax, p0[r]);
#pragma unroll
  for (int r = 0; r < 16; ++r) pmax = fmaxf(pmax, p1[r]);
  { auto rr = __builtin_amdgcn_permlane32_swap(__float_as_uint(pmax), __float_as_uint(pmax), false, false);
    pmax = fmaxf(__uint_as_float(rr[0]), __uint_as_float(rr[1])); }
  if (__builtin_expect(__all(pmax - m_reg <= THR / SCALE), 1)) { mn = m_reg; alpha = 1.f; }
  else { mn = fmaxf(m_reg, pmax); alpha = __builtin_amdgcn_exp2f((m_reg - mn) * C); m_reg = mn; }
  const float mnC = -mn * C;
#pragma unroll
  for (int r = 0; r < 16; ++r) p0[r] = fmaf(p0[r], C, mnC);
#pragma unroll
  for (int r = 0; r < 16; ++r) p1[r] = fmaf(p1[r], C, mnC);
#pragma unroll
  for (int r = 0; r < 16; ++r) p0[r] = __builtin_amdgcn_exp2f(p0[r]);
}
__device__ __forceinline__ void finishSM(f32x16& p0, f32x16& p1, float alpha, float& l_reg, bf16x8& pa0, bf16x8& pa1, bf16x8& pa2, bf16x8& pa3) {
#pragma unroll
  for (int r = 0; r < 16; ++r) p1[r] = __builtin_amdgcn_exp2f(p1[r]);
  float ps = 0;
#pragma unroll
  for (int r = 0; r < 16; ++r) ps += p0[r];
#pragma unroll
  for (int r = 0; r < 16; ++r) ps += p1[r];
  { auto rr = __builtin_amdgcn_permlane32_swap(__float_as_uint(ps), __float_as_uint(ps), false, false);
    ps = __uint_as_float(rr[0]) + __uint_as_float(rr[1]); }
  l_reg = l_reg * alpha + ps;
#define PK4(P, BASE, OUT) do { unsigned a0 = cvt_pk_bf16(P[BASE + 0], P[BASE + 1]), a1 = cvt_pk_bf16(P[BASE + 2], P[BASE + 3]);   \
    unsigned b0 = cvt_pk_bf16(P[BASE + 4], P[BASE + 5]), b1 = cvt_pk_bf16(P[BASE + 6], P[BASE + 7]);                              \
    auto r0 = __builtin_amdgcn_permlane32_swap(a0, b0, false, false); auto r1 = __builtin_amdgcn_permlane32_swap(a1, b1, false, false); \
    u32x4 w = {r0[0], r1[0], r0[1], r1[1]}; OUT = *reinterpret_cast<bf16x8*>(&w); } while (0)
  PK4(p0, 0, pa0); PK4(p0, 8, pa1); PK4(p1, 0, pa2); PK4(p1, 8, pa3);
#undef PK4
}
template <int ND0>
__device__ __forceinline__ void qkt(f32x16& p0, f32x16& p1, const char* Ks0, const bf16x8* qr, int r32, int hi, int kcb) {
  p0 = f32x16{}; p1 = f32x16{};
  const char* Ks = Ks0 + kcb;
#pragma unroll
  for (int d0 = 0; d0 < ND0; ++d0) { const int cb = (d0 * 16 + hi * 8) * 2;
    const bf16x8 b0 = *reinterpret_cast<const bf16x8*>(Ks + KSWZ(r32, cb));
    const bf16x8 b1 = *reinterpret_cast<const bf16x8*>(Ks + KSWZ(32 + r32, cb));
    p0 = __builtin_amdgcn_mfma_f32_32x32x16_bf16(b0, qr[d0], p0, 0, 0, 0);
    p1 = __builtin_amdgcn_mfma_f32_32x32x16_bf16(b1, qr[d0], p1, 0, 0, 0); }
}
__device__ __forceinline__ int v_st(int k, int c) { const int kk = (k & ~0xC) | ((k & 4) << 1) | ((k & 8) >> 1); return ((kk >> 3) * 4 + (c >> 5)) * 512 + ((kk & 7) * 32 + (c & 31)) * 2; }
__device__ __forceinline__ int v_rd_base(int lane) { return ((lane & 3) << 3) | (((lane >> 2) & 3) << 6) | (((lane >> 4) & 1) << 5) | (((lane >> 5) & 1) << 8); }
constexpr int v_rd_off(int d0, int ks, int half) { return d0 * 512 + ks * 4096 + half * 2048; }
template <int OFF> __device__ __forceinline__ s16x4 tr_read(int vb) {
  s16x4 r; asm volatile("ds_read_b64_tr_b16 %0, %1 offset:%2" : "=&v"(r) : "v"(vb), "i"(OFF) : "memory"); return r;
}
template <int D0> __device__ __forceinline__ void pv_one(f32x16& od, int vb, bf16x8 pa0, bf16x8 pa1, bf16x8 pa2, bf16x8 pa3) {
  const s16x4 l0 = tr_read<v_rd_off(D0, 0, 0)>(vb), h0 = tr_read<v_rd_off(D0, 0, 1)>(vb), l1 = tr_read<v_rd_off(D0, 1, 0)>(vb), h1 = tr_read<v_rd_off(D0, 1, 1)>(vb);
  const s16x4 l2 = tr_read<v_rd_off(D0, 2, 0)>(vb), h2 = tr_read<v_rd_off(D0, 2, 1)>(vb), l3 = tr_read<v_rd_off(D0, 3, 0)>(vb), h3 = tr_read<v_rd_off(D0, 3, 1)>(vb);
  asm volatile("s_waitcnt lgkmcnt(0)" ::: "memory"); SBAR();
#define PK(L, H) (bf16x8){L[0], L[1], L[2], L[3], H[0], H[1], H[2], H[3]}
  od = __builtin_amdgcn_mfma_f32_32x32x16_bf16(pa0, PK(l0, h0), od, 0, 0, 0);
  od = __builtin_amdgcn_mfma_f32_32x32x16_bf16(pa1, PK(l1, h1), od, 0, 0, 0);
  od = __builtin_amdgcn_mfma_f32_32x32x16_bf16(pa2, PK(l2, h2), od, 0, 0, 0);
  od = __builtin_amdgcn_mfma_f32_32x32x16_bf16(pa3, PK(l3, h3), od, 0, 0, 0);
#undef PK
}
__device__ __forceinline__ void pv_d0(f32x16* o, int vb, bf16x8 pa0, bf16x8 pa1, bf16x8 pa2, bf16x8 pa3) {
  pv_one<0>(o[0], vb, pa0, pa1, pa2, pa3); pv_one<1>(o[1], vb, pa0, pa1, pa2, pa3); pv_one<2>(o[2], vb, pa0, pa1, pa2, pa3); pv_one<3>(o[3], vb, pa0, pa1, pa2, pa3);
}
__device__ __forceinline__ void cmask(f32x16& p0, f32x16& p1, int kr, int qrow, int qcol, int hi, const float* bias) {
  const int rs = min(max(qrow - 4, 0), 56);
  if (kr < rs || kr >= rs + 8) {
#pragma unroll
    for (int r = 0; r < 16; ++r) { p0[r] = NEG; p1[r] = NEG; }
    return;
  }
  const int cs = min(max(qcol - 8, 0), 48);
  const float* brow = bias + (kr - qrow + 7) * 31 + (15 - qcol);
#pragma unroll
  for (int r = 0; r < 16; ++r) { const int kc = crow(r, hi);
    p0[r] = ((unsigned)(kc - cs) < 16u) ? p0[r] + brow[kc] : NEG;
    p1[r] = ((unsigned)(kc + 32 - cs) < 16u) ? p1[r] + brow[kc + 32] : NEG; }
}

struct Unit { int qrow0, qcol, kcol, vcol, ocol, seg0, seg1, NT, r0, win; float lam; };

template <int MODE>
__device__ __forceinline__ void attn_unit(const bf16_t* __restrict__ P, bf16_t* __restrict__ AO, const Unit u, char* lds) {
  constexpr int ND0 = (MODE == 1) ? 4 : 8;
  int tid = threadIdx.x; asm volatile("" : "+v"(tid));
  const int wid = __builtin_amdgcn_readfirstlane(tid >> 6), lane = tid & 63, r32 = lane & 31, hi = lane >> 5;
  const int sub = (MODE == 1) ? (wid >> 2) : 0, wq = (MODE == 1) ? (wid & 3) : wid;
  char* V_lds = lds; char* K_lds = lds + NSLOT * SHM_V;
  float* wsf = (float*)(lds + OFF_WS) + wid * 64; float* li_l = wsf; float* al_l = wsf + 32;
  const float* bias = (const float*)(lds + OFF_BIAS);
  float m_reg = NEG, l_reg = 0; f32x16 o[4] = {}; bf16x8 qr[ND0];
  const bf16_t* Qw = P + (size_t)(u.qrow0 + wq * QBLK + r32) * INW + u.qcol + sub * 64 + hi * 8;
#pragma unroll
  for (int d0 = 0; d0 < ND0; ++d0) qr[d0] = *reinterpret_cast<const bf16x8*>(Qw + d0 * 16);
  const int kcb = sub * 128;
  const int sr = tid >> 4, sc = (tid & 15) * 8, vst0 = v_st(sr, sc), vst1 = v_st(32 + sr, sc);
  const int vb0 = (int)(uintptr_t)V_lds + v_rd_base(lane);
  const unsigned kgo = (unsigned)((sr * INW + u.kcol + sc) * 2), vgo = (unsigned)((sr * INW + u.vcol + sc) * 2);
  constexpr int SD = (MODE == 2) ? 1 : 2;
  struct { bf16x8 vs0, vs1, ks0, ks1; } sr_[SD];
#define TROW(t) ((size_t)((t) < 4 ? u.seg0 + 64 * (t) : u.seg1 + 64 * ((t) - 4)) * (INW * 2))
#define SLOAD(i, t) do { const char* tb_ = (const char*)P + TROW(t); sr_[i].vs0 = *reinterpret_cast<const bf16x8*>(tb_ + vgo); sr_[i].vs1 = *reinterpret_cast<const bf16x8*>(tb_ + 32 * INW * 2 + vgo); \
    sr_[i].ks0 = *reinterpret_cast<const bf16x8*>(tb_ + kgo); sr_[i].ks1 = *reinterpret_cast<const bf16x8*>(tb_ + 32 * INW * 2 + kgo); } while (0)
#define SWRITE(so, i) do { *(bf16x8*)(V_lds + (so) + vst0) = sr_[i].vs0; *(bf16x8*)(V_lds + (so) + vst1) = sr_[i].vs1; const int kc = sc * 2; \
    *(bf16x8*)(K_lds + (so) + KSWZ(sr, kc)) = sr_[i].ks0; *(bf16x8*)(K_lds + (so) + KSWZ(32 + sr, kc)) = sr_[i].ks1; } while (0)
#define ROT() do { sP = sC; sC = sN; sN = (sN == (NSLOT - 1) * SHM_V) ? 0 : sN + SHM_V; } while (0)
#define SWAIT() do { if (SD == 2) asm volatile("s_waitcnt vmcnt(4)" ::: "memory"); else asm volatile("s_waitcnt vmcnt(0)" ::: "memory"); } while (0)
#define RESC(a) do { if (__any((a) < 1.f)) { if (hi == 0) al_l[r32] = (a); asm volatile("s_waitcnt lgkmcnt(0)" ::: "memory"); \
    _Pragma("unroll") for (int d = 0; d < 4; ++d) _Pragma("unroll") for (int r = 0; r < 16; ++r) o[d][r] *= al_l[crow(r, hi)]; } } while (0)
  const int qrow_g = u.r0 + (wid >> 1), qcol_g = 32 * (wid & 1) + r32;
#define CM(P0, P1, t) do { if (MODE == 2 && u.win && (t) >= 4) cmask(P0, P1, u.seg1 / 64 % 64 + (t) - 4, qrow_g, qcol_g, hi, bias); } while (0)
  f32x16 pA0, pA1, pB0, pB1; float mnA, mnB, alA, alB; bf16x8 pa0, pa1, pa2, pa3; const int NT = u.NT;
  constexpr int SE = 0, SO = SD - 1;
  int sP = 0, sC = 0, sN = SHM_V;
  SLOAD(SE, 0); asm volatile("s_waitcnt vmcnt(0)" ::: "memory"); SWRITE(0, SE); __syncthreads();
  qkt<ND0>(pA0, pA1, K_lds, qr, r32, hi, kcb); partialSM<MODE>(pA0, pA1, m_reg, mnA, alA);
  SLOAD(SO, 1); if (SD == 2 && 2 < NT) SLOAD(SE, 2);
  SWAIT(); SWRITE(SHM_V, SO); __syncthreads();
  sP = 0; sC = SHM_V; sN = 2 * SHM_V;
  for (int j = 1; j + 1 < NT; j += 2) {
    SBAR(); qkt<ND0>(pB0, pB1, K_lds + sC, qr, r32, hi, kcb);
    finishSM(pA0, pA1, alA, l_reg, pa0, pa1, pa2, pa3); SBAR();
    SLOAD(SO, j + SD); SBAR();
    pv_d0(o, vb0 + sP, pa0, pa1, pa2, pa3); CM(pB0, pB1, j); partialSM<MODE>(pB0, pB1, m_reg, mnB, alB);
    SWAIT(); SWRITE(sN, SE);
    RESC(alB); __syncthreads(); ROT();
    SBAR(); qkt<ND0>(pA0, pA1, K_lds + sC, qr, r32, hi, kcb);
    finishSM(pB0, pB1, alB, l_reg, pa0, pa1, pa2, pa3); SBAR();
    if (SD == 1 || j + 3 < NT) SLOAD(SE, j + 1 + SD); SBAR();
    pv_d0(o, vb0 + sP, pa0, pa1, pa2, pa3); CM(pA0, pA1, j + 1); partialSM<MODE>(pA0, pA1, m_reg, mnA, alA);
    SWAIT(); SWRITE(sN, SO);
    RESC(alA); __syncthreads(); ROT();
  }
  SBAR(); qkt<ND0>(pB0, pB1, K_lds + sC, qr, r32, hi, kcb);
  finishSM(pA0, pA1, alA, l_reg, pa0, pa1, pa2, pa3); SBAR();
  pv_d0(o, vb0 + sP, pa0, pa1, pa2, pa3); CM(pB0, pB1, NT - 1); partialSM<MODE>(pB0, pB1, m_reg, mnB, alB);
  RESC(alB);
  finishSM(pB0, pB1, alB, l_reg, pa0, pa1, pa2, pa3); SBAR();
  pv_d0(o, vb0 + sC, pa0, pa1, pa2, pa3);
  if (hi == 0) li_l[r32] = l_reg; asm volatile("s_waitcnt lgkmcnt(0)" ::: "memory");
  float rli[16];
#pragma unroll
  for (int r = 0; r < 16; ++r) rli[r] = __builtin_amdgcn_rcpf(li_l[crow(r, hi)]);
  bf16_t* Ow = AO + (size_t)(u.qrow0 + wq * QBLK) * DM + u.ocol;
  if (MODE == 1) {
    float* X = (float*)lds;
    __syncthreads();
    if (sub == 1) {
#pragma unroll
      for (int d0 = 0; d0 < 4; ++d0)
#pragma unroll
        for (int r = 0; r < 16; ++r) X[((d0 * 16 + r) * 4 + wq) * 64 + lane] = o[d0][r] * rli[r];
    }
    __syncthreads();
    if (sub == 0) {
#pragma unroll
      for (int r = 0; r < 16; ++r) { const int orow = crow(r, hi);
#pragma unroll
        for (int d0 = 0; d0 < 4; ++d0) { const float v = o[d0][r] * rli[r] - u.lam * X[((d0 * 16 + r) * 4 + wq) * 64 + lane];
          Ow[(size_t)orow * DM + d0 * 32 + r32] = (bf16_t)(cvt_pk_bf16(v, 0.f) & 0xffffu); } }
    }
  } else {
#pragma unroll
    for (int r = 0; r < 16; ++r) { const int orow = crow(r, hi);
#pragma unroll
      for (int d0 = 0; d0 < 4; ++d0) Ow[(size_t)orow * DM + d0 * 32 + r32] = (bf16_t)(cvt_pk_bf16(o[d0][r] * rli[r], 0.f) & 0xffffu); }
  }
#undef TROW
#undef SLOAD
#undef SWRITE
#undef ROT
#undef SWAIT
#undef RESC
#undef CM
}
#undef KSWZ
#undef SBAR
}

__device__ __forceinline__ void phase_attn(int l, bool with_ctx, int ctr_off, int u_lo = 0, int u_hi = 100000) {
    const KArgs ap = get_args(); Ctx F = make_ctx(ap);
    const bf16_t* P = (const bf16_t*)(F.ws + WS_P); bf16_t* AO = (bf16_t*)(F.ws + WS_AO);
    unsigned* ctr0 = (unsigned*)(F.ws + WS_CTL) + 256 + l * 256 + ctr_off * 4;
    const float lam = ((const float*)(F.ws + WS_SCAL))[l];
    char* lds = (char*)lds_raw;
    volatile unsigned* uw = (volatile unsigned*)(lds + fa::OFF_UNIT);
    const int NUX = with_ctx ? 85 : 80;
    const int myx = (int)((unsigned)__builtin_amdgcn_s_getreg((3 << 11) | 20) & 7u);
    const int bidn = F.gw / NWAVES, sj = bidn >> 3;
    const bool stat = (F.G == 256) && (u_lo == 0) && (u_hi > 640);
    int step = 0;
#pragma unroll 1
    for (int qi = 0; qi < (stat ? 1 : 8); ++qi) {
        const int x = stat ? (bidn & 7) : ((myx + qi) & 7);
        for (;;) {
            int i;
            __syncthreads();
            if (stat) {
                if (step == 0) i = sj;
                else if (sj < 24) i = (step == 1) ? 32 + sj : 1 << 20;
                else i = (step <= 3) ? 56 + 3 * (sj - 24) + (step - 1) : ((step == 4 && sj < 29) ? 80 + (sj - 24) : 1 << 20);
                ++step;
            } else {
                if (F.tid == 0) *uw = atomicAdd(ctr0 + 16 * x, 1u);
                __syncthreads();
                i = (int)*uw;
            }
            if (i >= NUX) break;
            fa::Unit u; u.lam = lam; u.win = 0; u.r0 = 0; u.seg1 = 0;
            if (i < 32) {
                const int b = x >> 2, h = x & 3, qb = i;
                if (u_lo <= 192 && 192 < u_hi) {
                u.qrow0 = b * SEQ + qb * 128; u.qcol = OFF_BQ + h * 128; u.kcol = OFF_BK + h * 128; u.vcol = OFF_BV + h * 128; u.ocol = 768 + h * 128;
                u.seg0 = ML + b * CTX; u.seg1 = b * SEQ; u.NT = 68;
                fa::attn_unit<1>(P, AO, u, lds); }
            } else if (i < 56) {
                const int st = x >> 1, b = st >> 1, kvh = st & 1, w = (x & 1) * 24 + (i - 32), h = kvh * 3 + w / 16, qb = w % 16;
                if (u_lo <= 0 && 0 < u_hi) {
                u.qrow0 = b * SEQ + qb * 256; u.qcol = OFF_AQ + h * 128; u.kcol = OFF_AK + kvh * 128; u.vcol = OFF_AV + kvh * 128; u.ocol = h * 128;
                u.seg0 = ML + b * CTX; u.seg1 = b * SEQ; u.NT = 68;
                fa::attn_unit<0>(P, AO, u, lds); }
            } else if (i < 80) {
                const int v = x * 24 + (i - 56), b = v / 96, h = (v % 96) / 16, qb = v % 16;
                const int r0 = qb * 4, rbase = min(max(r0 - 4, 0), 52);
                if (u_lo <= 448 && 448 < u_hi) {
                u.qrow0 = b * SEQ + qb * 256; u.qcol = OFF_CQ + h * 128; u.kcol = OFF_CK + h * 128; u.vcol = OFF_CV + h * 128; u.ocol = 1280 + h * 128;
                u.seg0 = ML + b * CTX; u.seg1 = b * SEQ + rbase * 64; u.NT = 16; u.r0 = r0; u.win = 1;
                { const float* rb = ap->in[I_CRB] + ((size_t)l * 6 + h) * 465; float* bl = (float*)(lds + fa::OFF_BIAS);
                  if (F.tid < 465) bl[F.tid] = rb[F.tid] * 11.313708498984761f; }
                fa::attn_unit<2>(P, AO, u, lds); }
            } else if (u_hi > 640) {
                const int v = x * 5 + (i - 80);
                u.NT = 4;
                if (v < 12) { const int b = v / 6, h = v % 6;
                    u.qrow0 = ML + b * CTX; u.qcol = OFF_AQ + h * 128; u.kcol = OFF_AK + (h / 3) * 128; u.vcol = OFF_AV + (h / 3) * 128; u.ocol = h * 128; u.seg0 = ML + b * CTX;
                    fa::attn_unit<0>(P, AO, u, lds);
                } else if (v < 28) { const int w = v - 12, b = w / 8, h = (w % 8) / 2, qb = w % 2;
                    u.qrow0 = ML + b * CTX + qb * 128; u.qcol = OFF_BQ + h * 128; u.kcol = OFF_BK + h * 128; u.vcol = OFF_BV + h * 128; u.ocol = 768 + h * 128; u.seg0 = ML + b * CTX;
                    fa::attn_unit<1>(P, AO, u, lds);
                } else { const int w = v - 28, b = w / 6, h = w % 6;
                    u.qrow0 = ML + b * CTX; u.qcol = OFF_CQ + h * 128; u.kcol = OFF_CK + h * 128; u.vcol = OFF_CV + h * 128; u.ocol = 1280 + h * 128; u.seg0 = ML + b * CTX;
                    fa::attn_unit<0>(P, AO, u, lds);
                }
            }
        }
    }
}

__device__ __forceinline__ void phase_n3(int l, int nrows) {
    const KArgs ap = get_args(); Ctx F = make_ctx(ap);
#define a (*ap)
    bf16_t* AO = (bf16_t*)(F.ws + WS_AO);
    const float* ag = a.in[I_AOG] + l * 768; const float* bg = a.in[I_BOG] + l * 128; const float* cgn = a.in[I_COG] + l * 768;
    const float bmul = 1.f - ((l == 0) ? 0.2f : 0.35550906f);
    for (int row = (F.gw / NWAVES) + F.G * F.wave; row < nrows; row += F.NGW) {
        u32x4* pr = (u32x4*)(AO + (size_t)row * DM) + F.lane;
        float v[4][8]; float ss[4];
#pragma unroll
        for (int j = 0; j < 4; ++j) { const u32x4 w = pr[64 * j];
            v[j][0] = bf_lo(w.x); v[j][1] = bf_hi(w.x); v[j][2] = bf_lo(w.y); v[j][3] = bf_hi(w.y); v[j][4] = bf_lo(w.z); v[j][5] = bf_hi(w.z); v[j][6] = bf_lo(w.w); v[j][7] = bf_hi(w.w);
            float s = 0.f;
#pragma unroll
            for (int e = 0; e < 8; ++e) s += v[j][e] * v[j][e];
            ss[j] = s; }
        const bool lo = F.lane < 32;
        const float sa = wave_sum(ss[0] + (lo ? ss[1] : 0.f));
        const float sc = wave_sum(ss[3] + (lo ? 0.f : ss[2]));
        float sb = lo ? ss[2] : ss[1];
        sb = group_sum<16>(sb);
        const float ra = rsqrtf(sa * (1.f / 768.f) + RMS_EPS), rc = rsqrtf(sc * (1.f / 768.f) + RMS_EPS), rb = rsqrtf(sb * (1.f / 128.f) + RMS_EPS) * bmul;
#pragma unroll
        for (int j = 0; j < 4; ++j) {
            const int col = j * 512 + F.lane * 8;
            float r; const float* gp;
            if (col < 768) { r = ra; gp = ag + col; } else if (col < 1280) { r = rb; gp = bg + ((col - 768) & 127); } else { r = rc; gp = cgn + (col - 1280); }
            const f32x4 g0 = *(const f32x4*)gp, g1 = *(const f32x4*)(gp + 4);
            u32x4 w; w.x = cvt_pk_bf16(v[j][0] * r * g0.x, v[j][1] * r * g0.y); w.y = cvt_pk_bf16(v[j][2] * r * g0.z, v[j][3] * r * g0.w);
            w.z = cvt_pk_bf16(v[j][4] * r * g1.x, v[j][5] * r * g1.y); w.w = cvt_pk_bf16(v[j][6] * r * g1.z, v[j][7] * r * g1.w);
            pr[64 * j] = w;
        }
    }
}

#undef a
constexpr int N_PHASES = 1 + 12 * DEPTH;

#define PH_IN(k) (lo <= (k) && (k) < hi)

#define XB_TMO      128
#define XB_XCNT(j)  (256  + 64 * (j))
#define XB_XSUB(j)  (1280 + 64 * (j))
#define XB_XGEN(j)  (2304 + 64 * (j))
#define XB_TOP      3328
#define XB_TOPGEN   3392
#define XCD_BAR_WORDS 3456
#define XB_SPIN_CAP (1u << 18)
__device__ __forceinline__ unsigned xb_ld(unsigned* p)              { return __hip_atomic_load(p, __ATOMIC_RELAXED, __HIP_MEMORY_SCOPE_AGENT); }
__device__ __forceinline__ unsigned xb_add(unsigned* p, unsigned v) { return __hip_atomic_fetch_add(p, v, __ATOMIC_RELAXED, __HIP_MEMORY_SCOPE_AGENT); }
__device__ __forceinline__ unsigned xb_xcc_id() { return (unsigned)__builtin_amdgcn_s_getreg((3 << 11) | 20) & 0xFu; }
#define XB_SPIN(cond, bar) do { unsigned _sp = 0; while (cond) { __builtin_amdgcn_s_sleep(1); \
    if ((++_sp & 255u) == 0u) { if (xb_ld(&(bar)[XB_TMO])) break; if (_sp > XB_SPIN_CAP) { atomicAdd(&(bar)[XB_TMO], 1u); break; } } } } while (0)
struct XcdBarrier { unsigned* bar; unsigned x; volatile LAS unsigned* st; };
__device__ __forceinline__ XcdBarrier xcd_barrier_post(unsigned* bar, volatile LAS unsigned* st) {
    XcdBarrier b; b.bar = bar; b.x = xb_xcc_id(); b.st = st;
    if (threadIdx.x == 0) (void)xb_add(&bar[XB_XCNT(b.x)], 1u);
    return b;
}
__device__ __forceinline__ void xcd_barrier_complete(unsigned* bar, unsigned x, unsigned& nloc, unsigned& nx) {
    const unsigned G = gridDim.x * gridDim.y * gridDim.z;
    unsigned sum, cnt, mine, sp = 0u;
    for (;;) {
        sum = 0u; cnt = 0u; mine = 0u;
#pragma unroll
        for (unsigned j = 0; j < 16; ++j) { const unsigned c = xb_ld(&bar[XB_XCNT(j)]); sum += c; cnt += (c > 0u) ? 1u : 0u; mine = (j == x) ? c : mine; }
        if (sum == G) break;
        __builtin_amdgcn_s_sleep(1);
        if ((++sp & 255u) == 0u) { if (xb_ld(&bar[XB_TMO])) break; if (sp > XB_SPIN_CAP) { atomicAdd(&bar[XB_TMO], 1u); break; } }
    }
    nloc = mine > 0u ? mine : 1u; nx = cnt > 0u ? cnt : 1u;
}
__device__ __forceinline__ void xcd_barrier(const XcdBarrier& b) {
    asm volatile("s_waitcnt vmcnt(0)" ::: "memory");
    __syncthreads();
    if (threadIdx.x == 0) {
        unsigned* bar = b.bar;
        __builtin_amdgcn_s_waitcnt(0);
        unsigned nloc = b.st[0], nx = b.st[1];
        if (nloc == 0u) { xcd_barrier_complete(bar, b.x, nloc, nx); b.st[0] = nloc; b.st[1] = nx; }
        const unsigned old = xb_add(&bar[XB_XSUB(b.x)], 1u);
        const unsigned gen = old / nloc;
        if (old + 1u == (gen + 1u) * nloc) {
            __builtin_amdgcn_fence(__ATOMIC_RELEASE, "agent");
            asm volatile("s_waitcnt vmcnt(0)" ::: "memory");
            const unsigned og = xb_add(&bar[XB_TOP], 1u);
            const unsigned tg = og / nx;
            if (og + 1u == (tg + 1u) * nx) xb_add(&bar[XB_TOPGEN], 1u);
            else XB_SPIN(xb_ld(&bar[XB_TOPGEN]) == tg, bar);
            __builtin_amdgcn_fence(__ATOMIC_ACQUIRE, "agent");
            xb_add(&bar[XB_XGEN(b.x)], 1u);
            asm volatile("s_waitcnt vmcnt(0)" ::: "memory");
        } else {
            XB_SPIN(xb_ld(&bar[XB_XGEN(b.x)]) == gen, bar);
            __builtin_amdgcn_fence(__ATOMIC_ACQUIRE, "agent");
            asm volatile("s_waitcnt vmcnt(0)" ::: "memory");
        }
    }
    __syncthreads();
}
constexpr size_t WS_BAR = 4096;
constexpr int LDS_BARST = LDS_BYTES - 64;

#ifndef PROBE_A
#define PROBE_A -1
#define PROBE_B -1
#endif
#if PROBE_A >= 0
#define PH_STAMP(k) do { if (blockIdx.x == 0 && threadIdx.x == 0) ((unsigned long long*)(ws + WS_SCAL + 1024))[k] = __builtin_amdgcn_s_memrealtime(); } while (0)
#else
#define PH_STAMP(k) do { } while (0)
#endif
#define PH_SYNC(k) do { if (coop && (k) + 1 < hi) { if (coop == 2) cg::this_grid().sync(); else xcd_barrier(xbar); } PH_STAMP((k) + 1); } while (0)
template <int L>
__device__ __forceinline__ void layer_phases(LAS unsigned char* lds, unsigned char* ws, const float* xin, float* out, int lo, int hi, int coop, const XcdBarrier xbar) {
    constexpr bool last = (L == DEPTH - 1);
    constexpr int mrows_tail = last ? ML : MT;
    constexpr int P0 = 1 + 12 * L;
    unsigned char* wl = ws + WS_W + (size_t)L * WL_STRIDE;
    const float* MOD = (const float*)(ws + WS_MOD) + (size_t)L * 3 * MODW;
    const int G = (int)gridDim.x, bid = (int)blockIdx.x;
    if (PH_IN(P0 + 0)) { if (DUP == 8 && L == 0) { phase_norm(L, 0, MT, 0, 2); xcd_barrier(xbar); } phase_norm(L, 0, MT, L == 0 ? 0 : 11, L == 0 ? 2 : 0); PH_SYNC(P0 + 0); }
    if (PH_IN(P0 + 1)) {
        pg8::Gemm g{(const bf16_t*)(ws + WS_XN), (const bf16_t*)(wl + WO_GU1), MT, 2 * FF, DM};
        pg8::StaticOrder<MT, 2 * FF, DM> S; S.init(G, bid); pg8::EpiSwiglu E{(bf16_t*)(ws + WS_H), FF};
        pg8::gemm_phase(lds, g, S, E);
        if (DUP == 1 && L == 0) { xcd_barrier(xbar); pg8::gemm_phase(lds, g, S, E); }
        PH_SYNC(P0 + 1); }
    if (PH_IN(P0 + 2)) {
        pg8::Gemm g{(const bf16_t*)(ws + WS_H), (const bf16_t*)(wl + WO_D1), MT, DM, FF};
        pg8::SplitTailOrder<ML, MT, DM, FF, 11> S; S.init(G, bid); pg8::EpiResid E{L == 0 ? xin : (const float*)(ws + WS_X), (float*)(ws + WS_X), MOD + 2 * DM, 0.5f};
        if (DUP == 2 && L == 0) { pg8::EpiResid E0 = E; E0.coef = 0.f; pg8::gemm_phase(lds, g, S, E0); xcd_barrier(xbar); }
        pg8::gemm_phase(lds, g, S, E); PH_SYNC(P0 + 2); }
    if (PH_IN(P0 + 3)) { phase_norm(L, 3, MT, 11, L == 0 ? 1 : 0); PH_SYNC(P0 + 3); }
    if (PH_IN(P0 + 4)) {
        pg8::Gemm g{(const bf16_t*)(ws + WS_XN), (const bf16_t*)(wl + WO_IN), MT, INW, DM};
        pg8::StaticOrder<MT, INW, DM> S; S.init(G, bid); pg8::EpiQKV E{(bf16_t*)(ws + WS_P), INW, (const float*)(ws + WS_SCAL + 4096) + L * 768, (LAS float*)(lds + RING_BYTES)};
        pg8::gemm_phase(lds, g, S, E); PH_SYNC(P0 + 4); }
    if (PH_IN(P0 + 6)) { if (DUP == 3 && L == 0) { phase_attn(L, !last, 32); xcd_barrier(xbar); }
        if (DUP >= 5 && DUP <= 7 && L == 0) { phase_attn(L, !last, 32, DUP == 5 ? 0 : (DUP == 6 ? 192 : 448), DUP == 5 ? 192 : (DUP == 6 ? 448 : 640)); xcd_barrier(xbar); } phase_attn(L, !last, 0); PH_SYNC(P0 + 6); }
    if (PH_IN(P0 + 7)) { phase_n3(L, mrows_tail); PH_SYNC(P0 + 7); }
    if (PH_IN(P0 + 8)) {
        pg8::Gemm g{(const bf16_t*)(ws + WS_AO), (const bf16_t*)(wl + WO_OUT), mrows_tail, DM, DM};
        pg8::SplitTailOrder<ML, mrows_tail, DM, DM, 8> S; S.init(G, bid); pg8::EpiResid E{(const float*)(ws + WS_X), (float*)(ws + WS_X), MOD + 5 * DM, 1.f};
        pg8::gemm_phase(lds, g, S, E); PH_SYNC(P0 + 8); }
    if (PH_IN(P0 + 9)) { phase_norm(L, 6, mrows_tail, 8, 0); PH_SYNC(P0 + 9); }
    if (PH_IN(P0 + 10)) {
        pg8::Gemm g{(const bf16_t*)(ws + WS_XN), (const bf16_t*)(wl + WO_GU2), mrows_tail, 2 * FF, DM};
        pg8::StaticOrder<mrows_tail, 2 * FF, DM> S; S.init(G, bid); pg8::EpiSwiglu E{(bf16_t*)(ws + WS_H), FF};
        pg8::gemm_phase(lds, g, S, E); PH_SYNC(P0 + 10); }
    if (PH_IN(P0 + 11)) {
        pg8::Gemm g{(const bf16_t*)(ws + WS_H), (const bf16_t*)(wl + WO_D2), mrows_tail, DM, FF};
        pg8::SplitTailOrder<ML, mrows_tail, DM, FF, 11> S; S.init(G, bid); pg8::EpiResid E{(const float*)(ws + WS_X), last ? out : (float*)(ws + WS_X), MOD + 8 * DM, 0.5f};
        pg8::gemm_phase(lds, g, S, E); PH_SYNC(P0 + 11); }
}

__global__ void __launch_bounds__(NTHR, 2) mega_fwd(Args args) {
    LAS unsigned char* lds = (LAS unsigned char*)lds_raw;
    unsigned char* ws = args.ws;
    const int lo = args.ph_lo, hi = args.ph_hi, coop = args.coop;
    if (threadIdx.x < 16) ((LAS unsigned*)(lds + LDS_BYTES - 64))[threadIdx.x] = 0u;
    __syncthreads();
    XcdBarrier xbar; xbar.bar = (unsigned*)(ws + WS_BAR); xbar.x = 0; xbar.st = (volatile LAS unsigned*)(lds + LDS_BARST);
    if (coop) xbar = xcd_barrier_post((unsigned*)(ws + WS_BAR), (volatile LAS unsigned*)(lds + LDS_BARST));
    PH_STAMP(0);
    if (PH_IN(0)) { phase_prologue(); PH_SYNC(0); }
    layer_phases<0>(lds, ws, args.in[I_X], args.out, lo, hi, coop, xbar);
    layer_phases<1>(lds, ws, args.in[I_X], args.out, lo, hi, coop, xbar);
#if PROBE_A >= 0
    cg::this_grid().sync(); PH_STAMP(N_PHASES);
    if (blockIdx.x == 0 && threadIdx.x == 0) { const unsigned long long* ts = (const unsigned long long*)(ws + WS_SCAL + 1024); args.out[0] += (float)(ts[PROBE_B] - ts[PROBE_A]) * 0.01f; }
#endif
}

extern "C" void kernel_launch(void* const* d_in, const int* in_sizes, int n_in, void* d_out, int out_size, void* d_ws, size_t ws_size, hipStream_t stream) {
    static int grid = 0;
    if (grid == 0) {
        if (n_in != 23 || out_size != ML * DM || ws_size < WS_END) { fprintf(stderr, "kernel_launch: unexpected shapes n_in %d out %d ws %zu\n", n_in, out_size, ws_size); grid = -1; return; }
        int dev = 0, cus = 0, per_cu = 0;
        hipGetDevice(&dev); hipDeviceGetAttribute(&cus, hipDeviceAttributeMultiprocessorCount, dev);
        hipFuncSetAttribute((const void*)mega_fwd, hipFuncAttributeMaxDynamicSharedMemorySize, LDS_BYTES);
        hipOccupancyMaxActiveBlocksPerMultiprocessor(&per_cu, (const void*)mega_fwd, NTHR, LDS_BYTES);
        if (per_cu < 1) per_cu = 1;
        grid = cus * 1;
        (void)hipGetLastError();
    }
    if (grid < 0) return;
    hipMemsetAsync((char*)d_ws + WS_CTL, 0, CTL_ZERO_BYTES, stream);
    Args a{};
    for (int i = 0; i < 23; ++i) a.in[i] = (const float*)d_in[i];
    a.out = (float*)d_out; a.ws = (unsigned char*)d_ws;
#if MK_MULTI
    for (int ph = 0; ph < N_PHASES; ++ph) { a.ph_lo = ph; a.ph_hi = ph + 1; a.coop = 0; hipLaunchKernelGGL(mega_fwd, dim3(grid), dim3(NTHR), LDS_BYTES, stream, a); }
#else
    a.ph_lo = 0; a.ph_hi = N_PHASES; a.coop = 1;
    void* kargs[] = {&a};
    hipError_t e = hipLaunchCooperativeKernel((const void*)mega_fwd, dim3(grid), dim3(NTHR), kargs, LDS_BYTES, stream);
    if (e != hipSuccess) fprintf(stderr, "cooperative launch failed: %s (grid %d)\n", hipGetErrorString(e), grid);
#endif
}
```
